# Optimizing an MI355X kernel written in HIP

```python
import math
import jax, jax.numpy as jnp
from jax import lax
import numpy as np

D_MODEL = 1024
BATCH = 8
SEQ = 4096
DEPTH = 2
DEC_BATCH = 16
DEC_SEQ = 16
PAST_LEN = 2048

CHUNK = 64
Q_BLOCK = 128
N_A = DEPTH // 2
N_B = DEPTH - N_A
M_HEADS = 4
M_DK = D_MODEL // (2 * M_HEADS)
M_DV = D_MODEL // M_HEADS
M_QK = M_HEADS * M_DK
M_V = M_HEADS * M_DV
M_PROJ = 2 * M_QK + M_V + D_MODEL + 2 * M_HEADS
DA_HEADS = 8
DA_DH = D_MODEL // (2 * DA_HEADS)
DA_Q = DA_HEADS * 2 * DA_DH
FFN_HIDDEN = -(-8 * D_MODEL // (3 * 256)) * 256
N_BUCKETS = 32
MAX_DISTANCE = 128
EPS = 1e-6

kernel_name = 'yoco_mlstm_diffattn_stream_step'


def _rmsnorm(x, g):
    x32 = x.astype(jnp.float32)
    y = x32 * lax.rsqrt(jnp.mean(x32 * x32, axis=-1, keepdims=True) + EPS) * g.astype(jnp.float32)
    return y.astype(x.dtype)


def _t5_bucket(rel):
    half = N_BUCKETS // 2
    max_exact = half // 2
    ret = jnp.where(rel > 0, half, 0)
    n = jnp.abs(rel)
    large = max_exact + (jnp.log(jnp.maximum(n, 1).astype(jnp.float32) / max_exact)
                         / math.log(MAX_DISTANCE / max_exact) * (half - max_exact)).astype(jnp.int32)
    large = jnp.minimum(large, half - 1)
    return ret + jnp.where(n < max_exact, n, large)


def _mlstm_chunk(carry, xs):
    c0, n0, m0 = carry
    q, k, v, ig, lf = xs
    L = q.shape[2]
    b = jnp.cumsum(lf, axis=-1)
    causal = jnp.tril(jnp.ones((L, L), dtype=bool))
    d = jnp.where(causal, b[..., :, None] - b[..., None, :] + ig[..., None, :], -jnp.inf)
    g = b + m0[..., None]
    m = jnp.maximum(g, jnp.max(d, axis=-1))
    w_inter = jnp.exp(g - m)
    s = jnp.exp(d - m[..., None]) * jnp.einsum('bhtk,bhsk->bhts', q, k)
    num = w_inter[..., None] * jnp.einsum('bhtk,bhvk->bhtv', q, c0) + jnp.einsum('bhts,bhsv->bhtv', s, v)
    den = w_inter * jnp.einsum('bhtk,bhk->bht', q, n0) + jnp.sum(s, axis=-1)
    h = num / jnp.maximum(jnp.abs(den), jnp.exp(-m))[..., None]
    m_last = m[..., -1]
    w_state = jnp.exp(g[..., -1] - m_last)
    w_rows = jnp.exp(b[..., -1:] - b + ig - m_last[..., None])
    c_new = w_state[..., None, None] * c0 + jnp.einsum('bhs,bhsv,bhsk->bhvk', w_rows, v, k)
    n_new = w_state[..., None] * n0 + jnp.einsum('bhs,bhsk->bhk', w_rows, k)
    return (c_new, n_new, m_last), h


def _mlstm_scan(q, k, v, ig, lf, carry):
    B, S = q.shape[0], q.shape[1]
    L = min(CHUNK, S)
    nc = S // L
    f32 = jnp.float32
    chunks = lambda a: a.astype(f32).reshape(B, nc, L, M_HEADS, a.shape[-1]).transpose(1, 0, 3, 2, 4)
    gchunks = lambda a: a.astype(f32).reshape(B, nc, L, M_HEADS).transpose(1, 0, 3, 2)
    carry = tuple(c.astype(f32) for c in carry)
    carry, h = lax.scan(_mlstm_chunk, carry, (chunks(q), chunks(k), chunks(v), gchunks(ig), gchunks(lf)))
    h = h.transpose(1, 0, 3, 2, 4).reshape(B, S, M_HEADS, M_DV)
    return h, carry


def _mlstm_mixer(xn, w_in, b_gate, g_head, w_out, carry):
    B, S, _ = xn.shape
    p = xn @ w_in
    q = p[..., :M_QK].reshape(B, S, M_HEADS, M_DK)
    k = p[..., M_QK:2 * M_QK].reshape(B, S, M_HEADS, M_DK) * (M_DK ** -0.5)
    v = p[..., 2 * M_QK:2 * M_QK + M_V].reshape(B, S, M_HEADS, M_DV)
    o = p[..., 2 * M_QK + M_V:2 * M_QK + M_V + D_MODEL]
    gates = (p[..., 2 * M_QK + M_V + D_MODEL:] + b_gate).astype(jnp.float32)
    ig = gates[..., :M_HEADS]
    lf = jax.nn.log_sigmoid(gates[..., M_HEADS:])
    h, carry = _mlstm_scan(q, k, v, ig, lf, carry)
    h = _rmsnorm(h, g_head).astype(xn.dtype).reshape(B, S, M_V) * jax.nn.sigmoid(o)
    return h @ w_out, carry


def _diff_block(q, k_all, v_all, q_pos, k_pos, rel_bias, lam):
    s = jnp.einsum('bqhjd,bkhjd->bhjqk', q, k_all).astype(jnp.float32) * (DA_DH ** -0.5)
    bias = rel_bias.astype(jnp.float32)[_t5_bucket(k_pos[None, :] - q_pos[:, None])]
    bias = bias.transpose(2, 0, 1)[None, :, None]
    mask = (k_pos[None, :] // CHUNK) <= (q_pos[:, None] // CHUNK)
    p = jax.nn.softmax(jnp.where(mask, s + bias, -jnp.inf), axis=-1)
    a = p[:, :, 0] - lam * p[:, :, 1]
    return jnp.einsum('bhqk,bkhe->bqhe', a.astype(v_all.dtype), v_all)


def _diff_mixer(xn, k_all, v_all, q_pos, k_pos, rel_bias, w_q, lq1, lk1, lq2, lk2, g_head, w_o, layer):
    B, S, _ = xn.shape
    lam_init = 0.8 - 0.6 * math.exp(-0.3 * layer)
    f32 = jnp.float32
    lam = (jnp.exp(jnp.sum(lq1.astype(f32) * lk1.astype(f32)))
           - jnp.exp(jnp.sum(lq2.astype(f32) * lk2.astype(f32))) + lam_init)
    q = (xn @ w_q).reshape(B, S, DA_HEADS, 2, DA_DH)
    if S <= Q_BLOCK:
        o = _diff_block(q, k_all, v_all, q_pos, k_pos, rel_bias, lam)
    else:
        nb = S // Q_BLOCK
        qb = q.reshape(B, nb, Q_BLOCK, DA_HEADS, 2, DA_DH).transpose(1, 0, 2, 3, 4, 5)
        pb = q_pos.reshape(nb, Q_BLOCK)
        ob = lax.map(lambda a: _diff_block(a[0], k_all, v_all, a[1], k_pos, rel_bias, lam), (qb, pb))
        o = ob.transpose(1, 0, 2, 3, 4).reshape(B, S, DA_HEADS, 2 * DA_DH)
    o = _rmsnorm(o, g_head) * (1.0 - lam_init)
    return o.reshape(B, S, DA_Q) @ w_o


def _swiglu(xn, w_in, w_out):
    gu = xn @ w_in
    return (jax.nn.silu(gu[..., :FFN_HIDDEN]) * gu[..., FFN_HIDDEN:]) @ w_out


def _trunk(x, c0, n0, m0, past_k, past_v, norm_g, mlstm_w_in, mlstm_b_gate, mlstm_g_head, mlstm_w_out,
           kv_g, kv_w, rel_bias, diff_w_q, diff_lam_q1, diff_lam_k1, diff_lam_q2, diff_lam_k2,
           diff_g_head, diff_w_o, ffn_w_in, ffn_w_out):
    B, S, _ = x.shape
    past = past_k.shape[1]
    q_pos = past + jnp.arange(S, dtype=jnp.int32)
    k_pos = jnp.arange(past + S, dtype=jnp.int32)
    cs, ns, ms = [], [], []
    new_k = new_v = k_all = v_all = None
    for layer in range(DEPTH):
        h = _rmsnorm(x, norm_g[layer, 0])
        if layer < N_A:
            a = layer
            h, (c, n, m) = _mlstm_mixer(h, mlstm_w_in[a], mlstm_b_gate[a], mlstm_g_head[a], mlstm_w_out[a],
                                        (c0[a], n0[a], m0[a]))
            cs.append(c); ns.append(n); ms.append(m)
        else:
            bi = layer - N_A
            if bi == 0:
                kv = _rmsnorm(x, kv_g) @ kv_w
                new_k = kv[..., :DA_Q].reshape(B, S, DA_HEADS, 2, DA_DH)
                new_v = kv[..., DA_Q:].reshape(B, S, DA_HEADS, 2 * DA_DH)
                k_all = jnp.concatenate([past_k.astype(new_k.dtype), new_k], axis=1)
                v_all = jnp.concatenate([past_v.astype(new_v.dtype), new_v], axis=1)
            h = _diff_mixer(h, k_all, v_all, q_pos, k_pos, rel_bias, diff_w_q[bi], diff_lam_q1[bi],
                            diff_lam_k1[bi], diff_lam_q2[bi], diff_lam_k2[bi], diff_g_head[bi],
                            diff_w_o[bi], layer)
        x = x + _rmsnorm(h, norm_g[layer, 1])
        h = _swiglu(_rmsnorm(x, norm_g[layer, 2]), ffn_w_in[layer], ffn_w_out[layer])
        x = x + _rmsnorm(h, norm_g[layer, 3])
    return x, jnp.stack(cs), jnp.stack(ns), jnp.stack(ms), new_k, new_v


def setup_inputs(seed: int = 0) -> dict:
    key = jax.random.key(seed)
    ks = jax.random.split(key, 32)
    nrm = lambda k, shape, s=1.0: jax.random.normal(k, shape, jnp.float32) * s
    D = D_MODEL
    b_gate = jnp.concatenate([nrm(ks[10], (N_A, M_HEADS), 0.1),
                              3.0 + 3.0 * jax.random.uniform(ks[11], (N_A, M_HEADS), jnp.float32)], axis=-1)
    return {
        'x_prompt': nrm(ks[0], (BATCH, SEQ, D)),
        'x_sample': nrm(ks[1], (DEC_BATCH, DEC_SEQ, D)),
        'state_C': nrm(ks[2], (N_A, DEC_BATCH, M_HEADS, M_DV, M_DK), 0.5),
        'state_n': nrm(ks[3], (N_A, DEC_BATCH, M_HEADS, M_DK)),
        'state_m': nrm(ks[4], (N_A, DEC_BATCH, M_HEADS)),
        'cache_k': nrm(ks[5], (DEC_BATCH, PAST_LEN, DA_HEADS, 2, DA_DH)),
        'cache_v': nrm(ks[6], (DEC_BATCH, PAST_LEN, DA_HEADS, 2 * DA_DH)),
        'norm_g': 1.0 + nrm(ks[7], (DEPTH, 4, D), 0.02),
        'mlstm_w_in': nrm(ks[8], (N_A, D, M_PROJ), D ** -0.5),
        'mlstm_b_gate': b_gate,
        'mlstm_g_head': 1.0 + nrm(ks[12], (N_A, M_HEADS, M_DV), 0.02),
        'mlstm_w_out': nrm(ks[13], (N_A, M_V, D), M_V ** -0.5),
        'kv_g': 1.0 + nrm(ks[14], (D,), 0.02),
        'kv_w': nrm(ks[15], (D, 2 * DA_Q), D ** -0.5),
        'rel_bias': nrm(ks[16], (N_BUCKETS, DA_HEADS), 0.5),
        'diff_w_q': nrm(ks[17], (N_B, D, DA_Q), D ** -0.5),
        'diff_lam_q1': nrm(ks[18], (N_B, DA_DH), 0.1),
        'diff_lam_k1': nrm(ks[19], (N_B, DA_DH), 0.1),
        'diff_lam_q2': nrm(ks[20], (N_B, DA_DH), 0.1),
        'diff_lam_k2': nrm(ks[21], (N_B, DA_DH), 0.1),
        'diff_g_head': 1.0 + nrm(ks[22], (N_B, 2 * DA_DH), 0.02),
        'diff_w_o': nrm(ks[23], (N_B, DA_Q, D), DA_Q ** -0.5),
        'ffn_w_in': nrm(ks[24], (DEPTH, D, 2 * FFN_HIDDEN), D ** -0.5),
        'ffn_w_out': nrm(ks[25], (DEPTH, FFN_HIDDEN, D), FFN_HIDDEN ** -0.5),
    }


def reference(x_prompt, x_sample, state_C, state_n, state_m, cache_k, cache_v, norm_g, mlstm_w_in,
              mlstm_b_gate, mlstm_g_head, mlstm_w_out, kv_g, kv_w, rel_bias, diff_w_q, diff_lam_q1,
              diff_lam_k1, diff_lam_q2, diff_lam_k2, diff_g_head, diff_w_o, ffn_w_in, ffn_w_out):
    f32 = jnp.float32
    B = x_prompt.shape[0]
    c0 = jnp.zeros((N_A, B, M_HEADS, M_DV, M_DK), f32)
    n0 = jnp.zeros((N_A, B, M_HEADS, M_DK), f32)
    m0 = jnp.zeros((N_A, B, M_HEADS), f32)
    empty_k = jnp.zeros((B, 0, DA_HEADS, 2, DA_DH), x_prompt.dtype)
    empty_v = jnp.zeros((B, 0, DA_HEADS, 2 * DA_DH), x_prompt.dtype)
    y_prompt, p_C, p_n, p_m, p_k, p_v = _trunk(
        x_prompt, c0, n0, m0, empty_k, empty_v, norm_g, mlstm_w_in, mlstm_b_gate, mlstm_g_head,
        mlstm_w_out, kv_g, kv_w, rel_bias, diff_w_q, diff_lam_q1, diff_lam_k1, diff_lam_q2, diff_lam_k2,
        diff_g_head, diff_w_o, ffn_w_in, ffn_w_out)
    y_sample, s_C, s_n, s_m, s_k, s_v = _trunk(
        x_sample, state_C, state_n, state_m, cache_k, cache_v, norm_g, mlstm_w_in, mlstm_b_gate,
        mlstm_g_head, mlstm_w_out, kv_g, kv_w, rel_bias, diff_w_q, diff_lam_q1, diff_lam_k1, diff_lam_q2,
        diff_lam_k2, diff_g_head, diff_w_o, ffn_w_in, ffn_w_out)
    return (y_prompt, y_sample, p_C, p_n, p_m, p_k, p_v, s_C, s_n, s_m, s_k, s_v)
```

```cpp
#define MK_N_LAUNCHES 1
#include <hip/hip_runtime.h>
#include <cstdio>
#include <cstdint>
#include <cmath>

#ifndef MK_N_LAUNCHES
#define MK_N_LAUNCHES 1
#endif

constexpr int DM = 1024;
constexpr int TP = 32768, TSM = 256, TT = TP + TSM;
constexpr int PSEQ = 4096, PAST = 2048, SSEQ = 16;
constexpr int MHEADS = 4, MDK = 128, MDV = 256, NPROJ = 3080, NP0 = 3072;
constexpr int AHEADS = 8;
constexpr int FFH = 2816, FF2 = 5632;
constexpr float EPS = 1e-6f;
constexpr float LOG2E = 1.4426950408889634f;
constexpr float QSCALE = 0.125f * LOG2E;
constexpr float LAM_INIT = 0.35550906759096926f;
constexpr int NCH_P = 2048, NCH_ALL = 2112;

constexpr size_t O_YP = 0, O_YS = 33554432, O_PC = 33816576, O_PN = 34865152, O_PM = 34869248, O_PK = 34869280, O_PV = 68423712,
                 O_SC = 101978144, O_SN = 104075296, O_SM = 104083488, O_SK = 104083552, O_SV = 104345696, O_END = 104607840;

constexpr size_t MiB = 1u << 20;
constexpr size_t WS_CTL = 0, CTL_ZERO_BYTES = 1 * MiB;
constexpr size_t WS_GATES = 1 * MiB;
constexpr size_t WS_BCUM = 2 * MiB + 256 * 1024;
constexpr size_t WS_MST = 3 * MiB;
constexpr size_t WS_NST = 3 * MiB + 256 * 1024;
constexpr size_t WS_RS = 4 * MiB + 512 * 1024;
constexpr size_t WS_W = 6 * MiB;
constexpr size_t WS_WIN0 = WS_W, WS_WOUT0 = WS_W + 6 * MiB, WS_FIN0 = WS_W + 8 * MiB, WS_FOUT0 = WS_W + 19 * MiB, WS_KVQ = WS_W + 25 * MiB,
                 WS_WO1 = WS_W + 31 * MiB, WS_FIN1 = WS_W + 33 * MiB, WS_FOUT1 = WS_W + 44 * MiB;
constexpr size_t WS_R1 = 56 * MiB;
constexpr size_t WS_R2 = 250 * MiB;
constexpr size_t WS_XB = WS_R2 + 66 * MiB;
constexpr size_t WS_R3 = 382 * MiB;
constexpr size_t WS_END = 447 * MiB;

#define LAS __attribute__((address_space(3)))
#define GAS __attribute__((address_space(1)))
namespace pg8 {
#define PG8_LAS __attribute__((address_space(3)))
typedef unsigned short bf16_t;
typedef short bf16x8 __attribute__((ext_vector_type(8)));
typedef float f32x4 __attribute__((ext_vector_type(4)));
typedef unsigned u32x4 __attribute__((ext_vector_type(4)));
constexpr int BM = 256, BK = 64, HALF = 128, HTB = HALF * BK * 2  , STAGE_BYTES = 8 * HTB, NXCD = 8, WGM = 8;

__host__ __device__ __forceinline__ int lds_byte(int r, int c) { const int st = (r >> 4) * 2 + (c >> 5), rr = r & 15, cc = c & 31, ob = rr * 64 + cc * 2; return st * 1024 + (ob ^ (((ob >> 9) & 1) << 5)); }
__host__ __device__ __forceinline__ void stage_rc(int b, int& R, int& C) { const int st = b / 1024, sb = b % 1024, swz = sb ^ (((sb >> 9) & 1) << 5); R = (st >> 1) * 16 + swz / 64; C = (st & 1) * 32 + (swz % 64) / 2; }
__host__ __device__ __forceinline__ int perm32(int rho) { const int n = rho >> 4, i = rho & 15; return 8 * (i >> 2) + 4 * n + (i & 3); }

struct Unit { int pm, pn; };
struct Gemm { const bf16_t* A; const bf16_t* Bt; int M, N, K; };

struct StaticOrder {
    int nM, nN, nwg, G, c;
    __host__ __device__ void init(int M, int N, int G_, int c_) { nM = M / BM; nN = N / BM; nwg = nM * nN; G = G_; c = c_; }
    __host__ __device__ bool next(int i, Unit& u) const {
        const long L = (long)i * G + c; if (L >= nwg) return false;
        int wgid = (int)L; { const int q = nwg / NXCD, r = nwg % NXCD, xcd = wgid % NXCD, off = wgid / NXCD; wgid = (xcd < r ? xcd * (q + 1) : r * (q + 1) + (xcd - r) * q) + off; }
        const int nig = WGM * nN, gid = wgid / nig, fm = gid * WGM, gsz = (nM - fm) < WGM ? (nM - fm) : WGM;
        u.pm = fm + ((wgid % nig) % gsz); u.pn = (wgid % nig) / gsz; return true;
    }
    __device__ __forceinline__ void a_ready(const Unit&) const {}
    __device__ __forceinline__ void done(const Unit&) const {}
};
struct SubOrder {
    StaticOrder S; int i0, n;
    __host__ __device__ bool next(int i, Unit& u) const { return i < n && S.next(i0 + i, u); }
    __device__ __forceinline__ void a_ready(const Unit&) const {}
    __device__ __forceinline__ void done(const Unit&) const {}
};
typedef float f32x2 __attribute__((ext_vector_type(2)));
typedef __bf16 bf16x2_t __attribute__((ext_vector_type(2)));
__device__ __forceinline__ unsigned cvt_pk_bf16(float lo, float hi) { f32x2 v = {lo, hi}; bf16x2_t b = __builtin_convertvector(v, bf16x2_t); return __builtin_bit_cast(unsigned, b); }
__device__ __forceinline__ float fast_sigmoid(float x) { return __builtin_amdgcn_rcpf(1.0f + __builtin_amdgcn_exp2f(-1.4426950408889634f * x)); }

struct EpiBf16T {
    static constexpr bool PERM = true, AFTER_DRAIN = false; static constexpr int NST = 16;
    bf16_t* O; int ldc; int m1_lo, m1_hi; float s1; int m2_lo;
    __device__ __forceinline__ void operator()(const f32x4 (&acc)[2][2][4][2], const Unit& u, int wr, int wc, int fr, int fq) const {
        const int row0 = u.pm * BM + wr * 64 + fr, col0 = u.pn * BM + wc * 32 + 8 * fq;
        const bool sg = u.pn >= m2_lo; const float sc = (u.pn >= m1_lo && u.pn < m1_hi) ? s1 : 1.0f;
#pragma unroll
        for (int ai = 0; ai < 2; ++ai)
#pragma unroll
            for (int m = 0; m < 4; ++m) { bf16_t* rowp = O + (size_t)(row0 + ai * HALF + m * 16) * ldc + col0;
#pragma unroll
                for (int bj = 0; bj < 2; ++bj) { f32x4 v0 = acc[ai][bj][m][0] * sc, v1 = acc[ai][bj][m][1] * sc;
                    if (sg) {
#pragma unroll
                        for (int i = 0; i < 4; ++i) { v0[i] = fast_sigmoid(v0[i]); v1[i] = fast_sigmoid(v1[i]); } }
                    u32x4 w; w.x = cvt_pk_bf16(v0[0], v0[1]); w.y = cvt_pk_bf16(v0[2], v0[3]); w.z = cvt_pk_bf16(v1[0], v1[1]); w.w = cvt_pk_bf16(v1[2], v1[3]);
                    *(u32x4*)(rowp + bj * HALF) = w; } }
    }
};
struct EpiSwiglu {
    static constexpr bool PERM = true, AFTER_DRAIN = false; static constexpr int NST = 8;
    bf16_t* O; int ldc; const float* rs;
    __device__ __forceinline__ void operator()(const f32x4 (&acc)[2][2][4][2], const Unit& u, int wr, int wc, int fr, int fq) const {
        const int row0 = u.pm * BM + wr * 64 + fr, col0 = u.pn * HALF + wc * 32 + 8 * fq;
        float rsv[2][4];
#pragma unroll
        for (int ai = 0; ai < 2; ++ai)
#pragma unroll
            for (int m = 0; m < 4; ++m) rsv[ai][m] = rs[row0 + ai * HALF + m * 16];
#pragma unroll
        for (int ai = 0; ai < 2; ++ai)
#pragma unroll
            for (int m = 0; m < 4; ++m) { bf16_t* rowp = O + (size_t)(row0 + ai * HALF + m * 16) * ldc + col0; const float rsc = rsv[ai][m];
                f32x4 r[2];
#pragma unroll
                for (int n = 0; n < 2; ++n) { const f32x4 g = acc[ai][0][m][n] * rsc, up = acc[ai][1][m][n] * rsc;
#pragma unroll
                    for (int i = 0; i < 4; ++i) r[n][i] = g[i] * fast_sigmoid(g[i]) * up[i]; }
                u32x4 w; w.x = cvt_pk_bf16(r[0][0], r[0][1]); w.y = cvt_pk_bf16(r[0][2], r[0][3]); w.z = cvt_pk_bf16(r[1][0], r[1][1]); w.w = cvt_pk_bf16(r[1][2], r[1][3]);
                *(u32x4*)rowp = w; }
    }
};
struct EpiKVQ {
    static constexpr bool PERM = true, AFTER_DRAIN = false; static constexpr int NST = 16;
    bf16_t* O; float* outp; float qscale; const float* rs;
    __device__ __forceinline__ void operator()(const f32x4 (&acc)[2][2][4][2], const Unit& u, int wr, int wc, int fr, int fq) const {
        const int row0 = u.pm * BM + wr * 64 + fr, col0 = u.pn * BM + wc * 32 + 8 * fq;
        const bool isq = u.pn >= 8; const float sc = isq ? qscale : 1.0f;
        float* f = nullptr;
        if (!isq && u.pm >= 128) { const bool isv = u.pn >= 4; const int c = (u.pn & 3) * BM + wc * 32 + 8 * fq;
            f = outp + (u.pm < 128 ? (isv ? O_PV : O_PK) + (size_t)u.pm * BM * 1024 : (isv ? O_SV : O_SK)) + c + (size_t)(wr * 64 + fr) * 1024; }
        float rsv[2][4];
#pragma unroll
        for (int ai = 0; ai < 2; ++ai)
#pragma unroll
            for (int m = 0; m < 4; ++m) rsv[ai][m] = rs[row0 + ai * HALF + m * 16] * sc;
#pragma unroll
        for (int ai = 0; ai < 2; ++ai)
#pragma unroll
            for (int m = 0; m < 4; ++m) { bf16_t* rowp = O + (size_t)(row0 + ai * HALF + m * 16) * 3072 + col0; const float rsc = rsv[ai][m];
#pragma unroll
                for (int bj = 0; bj < 2; ++bj) { const f32x4 v0 = acc[ai][bj][m][0] * rsc, v1 = acc[ai][bj][m][1] * rsc;
                    if (f) { float* fp = f + (size_t)(ai * HALF + m * 16) * 1024 + bj * HALF; *(f32x4*)fp = v0; *(f32x4*)(fp + 4) = v1; }
                    u32x4 w; w.x = cvt_pk_bf16(v0[0], v0[1]); w.y = cvt_pk_bf16(v0[2], v0[3]); w.z = cvt_pk_bf16(v1[0], v1[1]); w.w = cvt_pk_bf16(v1[2], v1[3]);
                    *(u32x4*)(rowp + bj * HALF) = w; } }
    }
};

template <class Epi, class Sched, bool ALIGN_EPI = false, bool SP2 = false, int DG = 0>
__device__ __forceinline__ void gemm_phase(PG8_LAS unsigned char* lds, const Gemm g, const Sched& S, const Epi& E) {
    const int tid = threadIdx.x, wid = __builtin_amdgcn_readfirstlane(tid >> 6), lane = tid & 63, wr = wid >> 2, wc = wid & 3, fr = lane & 15, fq = lane >> 4;
    const int K = g.K, nt = K / BK;
    unsigned voffA[2], voffB[2];
#pragma unroll
    for (int i = 0; i < 2; ++i) { int R, C; stage_rc(tid * 16 + i * 8192, R, C); const int Rb = Epi::PERM ? ((R & ~31) + perm32(R & 31)) : R;
        voffA[i] = (unsigned)(R * K + C) * 2u; voffB[i] = (unsigned)(Rb * K + C) * 2u; }
    const size_t kstep = (size_t)(BK * 2);
    const size_t hstep = (size_t)HALF * K * 2;
    const size_t tstep = 2 * hstep;
    const unsigned ldsw = (unsigned)wid * 1024u;
    const int aoff = lds_byte(wr * 64 + fr, fq * 8), boff = lds_byte(wc * 32 + fr, fq * 8);
#define PG8_SA(b, h) (((b) * 2 + (h)) * HTB)
#define PG8_SB(b, h) ((4 + (b) * 2 + (h)) * HTB)
#define PG8_STAGE(bufoff, gbase, voff) do { if constexpr (DG != 4) { _Pragma("unroll") for (int _i = 0; _i < 2; ++_i) \
        __builtin_amdgcn_global_load_lds((const unsigned*)((const char*)(gbase) + (voff)[_i]), (PG8_LAS unsigned*)(lds + (bufoff) + ldsw + _i * 8192), 16, 0, 0); } } while (0)
#define PG8_LDA(dst, b, h) do { _Pragma("unroll") for (int m = 0; m < 4; ++m) _Pragma("unroll") for (int k = 0; k < 2; ++k) dst[m][k] = *(const PG8_LAS bf16x8*)(lds + PG8_SA(b, h) + aoff + m * 2048 + k * 1024); } while (0)
#define PG8_LDB(dst, b, h) do { _Pragma("unroll") for (int n = 0; n < 2; ++n) _Pragma("unroll") for (int k = 0; k < 2; ++k) dst[n][k] = *(const PG8_LAS bf16x8*)(lds + PG8_SB(b, h) + boff + n * 2048 + k * 1024); } while (0)
#define PG8_MMA(ai, bj, At, Bt) do { __builtin_amdgcn_s_setprio(1); _Pragma("unroll") for (int m = 0; m < 4; ++m) _Pragma("unroll") for (int n = 0; n < 2; ++n) _Pragma("unroll") for (int k = 0; k < 2; ++k) { \
        if constexpr (DG != 3) acc[ai][bj][m][n] = __builtin_amdgcn_mfma_f32_16x16x32_bf16(Bt[n][k], At[m][k], acc[ai][bj][m][n], 0, 0, 0); else asm volatile("" :: "v"(Bt[n][k]), "v"(At[m][k])); } __builtin_amdgcn_s_setprio(0); } while (0)
#define PG8_WAIT_V(n) asm volatile("s_waitcnt vmcnt(" #n ")" ::: "memory")
#define PG8_WAIT_VE(f) asm volatile("s_cmp_lg_u32 %0, 0\n\ts_cbranch_scc1 1f\n\ts_waitcnt vmcnt(8)\n1:\n\ts_waitcnt vmcnt(%1)" :: "s"(f), "n"(8 + Epi::NST) : "memory", "scc")
#define PG8_WAIT_L(n) asm volatile("s_waitcnt lgkmcnt(" #n ")" ::: "memory")
#define PG8_BAR __builtin_amdgcn_s_barrier()
#define PG8_SCHED __builtin_amdgcn_sched_barrier(0)
    Unit cur, nxt; int ui = 0;
    if (!S.next(0, cur)) return;
    f32x4 acc[2][2][4][2];
#pragma unroll
    for (int a = 0; a < 2; ++a)
#pragma unroll
        for (int b = 0; b < 2; ++b)
#pragma unroll
            for (int m = 0; m < 4; ++m)
#pragma unroll
                for (int n = 0; n < 2; ++n) acc[a][b][m][n] = (f32x4){0.f, 0.f, 0.f, 0.f};
    bf16x8 At[4][2], B0[2][2], B1[2][2];
    const char* cA = (const char*)g.A + (size_t)cur.pm * tstep; const char* cB = (const char*)g.Bt + (size_t)cur.pn * tstep;
    S.a_ready(cur);
    if constexpr (SP2) {
        PG8_STAGE(PG8_SB(0, 0), cB, voffB); PG8_STAGE(PG8_SB(0, 1), cB + hstep, voffB); PG8_STAGE(PG8_SA(0, 0), cA, voffA); PG8_STAGE(PG8_SA(0, 1), cA + hstep, voffA);
        if (wr == 1) PG8_BAR;
        PG8_WAIT_V(2); PG8_BAR;
        PG8_STAGE(PG8_SB(1, 0), cB + kstep, voffB); PG8_STAGE(PG8_SA(1, 0), cA + kstep, voffA); PG8_STAGE(PG8_SB(1, 1), cB + hstep + kstep, voffB);
        PG8_WAIT_V(6); PG8_BAR;
    } else {
        PG8_STAGE(PG8_SB(0, 0), cB, voffB); PG8_STAGE(PG8_SA(0, 0), cA, voffA); PG8_STAGE(PG8_SB(0, 1), cB + hstep, voffB); PG8_STAGE(PG8_SA(0, 1), cA + hstep, voffA);
        if (wr == 1) PG8_BAR;
        PG8_WAIT_V(4); PG8_BAR;
        PG8_STAGE(PG8_SB(1, 0), cB + kstep, voffB); PG8_STAGE(PG8_SA(1, 0), cA + kstep, voffA); PG8_STAGE(PG8_SB(1, 1), cB + hstep + kstep, voffB);
        PG8_WAIT_V(6); PG8_BAR;
    }
    for (;;) {
        const bool has_next = S.next(ui + 1, nxt);
        const char* nA = has_next ? (const char*)g.A + (size_t)nxt.pm * tstep : cA; const char* nB = has_next ? (const char*)g.Bt + (size_t)nxt.pn * tstep : cB;
        for (int t = 0; t < nt; t += 2) {
            const bool last = (t == nt - 2);
            const char* a1 = cA + (size_t)(t + 1) * kstep;
            const char* a2 = last ? nA : cA + (size_t)(t + 2) * kstep; const char* b2 = last ? nB : cB + (size_t)(t + 2) * kstep;
            const char* a3 = a2 + kstep; const char* b3 = b2 + kstep;
            if (last && has_next) S.a_ready(nxt);
            const int fta = __builtin_amdgcn_readfirstlane(((t == 0) && (ui > 0)) ? 1 : 0);
            if constexpr (SP2) {
            PG8_LDB(B0, 0, 0); PG8_LDB(B1, 0, 1); PG8_SCHED; PG8_LDA(At, 0, 0); PG8_STAGE(PG8_SA(1, 1), a1 + hstep, voffA);
            PG8_WAIT_VE(fta);
            PG8_WAIT_L(0); PG8_BAR; PG8_MMA(0, 0, At, B0); PG8_MMA(0, 1, At, B1); PG8_BAR; PG8_SCHED;
            PG8_LDA(At, 0, 1); PG8_STAGE(PG8_SB(0, 0), b2, voffB); PG8_STAGE(PG8_SB(0, 1), b2 + hstep, voffB); PG8_STAGE(PG8_SA(0, 0), a2, voffA);
            PG8_WAIT_VE(fta);
            PG8_WAIT_L(0); PG8_BAR; PG8_MMA(1, 0, At, B0); PG8_MMA(1, 1, At, B1); PG8_BAR; PG8_SCHED;
            PG8_LDB(B0, 1, 0); PG8_LDB(B1, 1, 1); PG8_SCHED; PG8_LDA(At, 1, 0); PG8_STAGE(PG8_SA(0, 1), a2 + hstep, voffA);
            PG8_WAIT_V(8); PG8_WAIT_L(0); PG8_BAR; PG8_MMA(0, 0, At, B0); PG8_MMA(0, 1, At, B1); PG8_BAR; PG8_SCHED;
            PG8_LDA(At, 1, 1); PG8_STAGE(PG8_SB(1, 0), b3, voffB); PG8_STAGE(PG8_SB(1, 1), b3 + hstep, voffB); PG8_STAGE(PG8_SA(1, 0), a3, voffA);
            PG8_WAIT_V(8); PG8_WAIT_L(0); PG8_BAR; PG8_MMA(1, 0, At, B0); PG8_MMA(1, 1, At, B1); PG8_BAR; PG8_SCHED;
            } else {
            PG8_LDB(B0, 0, 0); PG8_SCHED; PG8_LDA(At, 0, 0); PG8_STAGE(PG8_SA(1, 1), a1 + hstep, voffA);
            PG8_WAIT_L(8); PG8_BAR; PG8_WAIT_L(0); PG8_MMA(0, 0, At, B0); PG8_BAR; PG8_SCHED;
            PG8_LDB(B1, 0, 1); PG8_STAGE(PG8_SB(0, 0), b2, voffB);
            PG8_BAR; PG8_WAIT_L(0); PG8_MMA(0, 1, At, B1); PG8_BAR;
            PG8_LDA(At, 0, 1); PG8_STAGE(PG8_SA(0, 0), a2, voffA);
            PG8_BAR; PG8_WAIT_L(0); PG8_MMA(1, 0, At, B0); PG8_BAR; PG8_SCHED;
            PG8_STAGE(PG8_SB(0, 1), b2 + hstep, voffB);
            PG8_WAIT_V(6); PG8_BAR; PG8_MMA(1, 1, At, B1); PG8_BAR;
            PG8_LDB(B0, 1, 0); PG8_SCHED; PG8_LDA(At, 1, 0); PG8_STAGE(PG8_SA(0, 1), a2 + hstep, voffA);
            PG8_WAIT_L(8); PG8_BAR; PG8_WAIT_L(0); PG8_MMA(0, 0, At, B0); PG8_BAR; PG8_SCHED;
            PG8_LDB(B1, 1, 1); PG8_STAGE(PG8_SB(1, 0), b3, voffB);
            PG8_BAR; PG8_WAIT_L(0); PG8_MMA(0, 1, At, B1); PG8_BAR;
            PG8_LDA(At, 1, 1); PG8_STAGE(PG8_SA(1, 0), a3, voffA);
            PG8_BAR; PG8_WAIT_L(0); PG8_MMA(1, 0, At, B0); PG8_BAR; PG8_SCHED;
            PG8_STAGE(PG8_SB(1, 1), b3 + hstep, voffB);
            PG8_WAIT_V(6); PG8_BAR; PG8_MMA(1, 1, At, B1); PG8_BAR;
            }
        }
        if constexpr (ALIGN_EPI) { if (wr == 0) PG8_BAR; }
        if constexpr (DG >= 2) {
#pragma unroll
            for (int a = 0; a < 2; ++a)
#pragma unroll
                for (int b = 0; b < 2; ++b)
#pragma unroll
                    for (int m = 0; m < 4; ++m)
#pragma unroll
                        for (int n = 0; n < 2; ++n) asm volatile("" :: "v"(acc[a][b][m][n]));
        } else
        if constexpr (!Epi::AFTER_DRAIN) { E(acc, cur, wr, wc, fr, fq); S.done(cur); }
        if (!has_next) break;
#pragma unroll
        for (int a = 0; a < 2; ++a)
#pragma unroll
            for (int b = 0; b < 2; ++b)
#pragma unroll
                for (int m = 0; m < 4; ++m)
#pragma unroll
                    for (int n = 0; n < 2; ++n) acc[a][b][m][n] = (f32x4){0.f, 0.f, 0.f, 0.f};
        cur = nxt; cA = nA; cB = nB; ++ui;
        if constexpr (ALIGN_EPI) { if (wr == 1) PG8_BAR; }
    }
    PG8_WAIT_V(0);
    if constexpr (!ALIGN_EPI) { if (wr == 0) PG8_BAR; }
    PG8_BAR;
    if constexpr (Epi::AFTER_DRAIN) { E.fused(acc, cur, wr, wc, fr, fq, lds, wid, lane); S.done(cur); }
#undef PG8_SA
#undef PG8_SB
#undef PG8_STAGE
#undef PG8_LDA
#undef PG8_LDB
#undef PG8_MMA
#undef PG8_WAIT_V
#undef PG8_WAIT_VE
#undef PG8_WAIT_L
#undef PG8_BAR
#undef PG8_SCHED
}
}
constexpr int NWAVES = 8;
constexpr int RING_BYTES = 157696;
constexpr int LDSCTL_OFF = RING_BYTES, MISC_OFF = LDSCTL_OFF + 320;
constexpr int LDS_BYTES = 159744;
constexpr int CW_ATQ = 16384;
constexpr int CW_GRP = 49152;
constexpr int CW_BAR = 4096;

typedef unsigned short bf16_t;
typedef short bf16x8 __attribute__((ext_vector_type(8)));
typedef short s16x4 __attribute__((ext_vector_type(4)));
typedef float f32x2 __attribute__((ext_vector_type(2)));
typedef float f32x4 __attribute__((ext_vector_type(4)));
typedef float f32x16 __attribute__((ext_vector_type(16)));
typedef unsigned u32x2 __attribute__((ext_vector_type(2)));
typedef unsigned u32x4 __attribute__((ext_vector_type(4)));
typedef GAS unsigned gu32;
#define RLX_AGENT __ATOMIC_RELAXED, __HIP_MEMORY_SCOPE_AGENT
#define LDS_WAIT() asm volatile("s_waitcnt lgkmcnt(0)" ::: "memory")
#define VM_WAIT() asm volatile("s_waitcnt vmcnt(0)" ::: "memory")
using pg8::cvt_pk_bf16;
__device__ __forceinline__ float bflo(unsigned w) { return __uint_as_float(w << 16); }
__device__ __forceinline__ float bfhi(unsigned w) { return __uint_as_float(w & 0xffff0000u); }
__device__ __forceinline__ int crow(int r, int hi) { return (r & 3) + 8 * (r >> 2) + 4 * hi; }
__device__ __forceinline__ float wave_sum(float v) {
#pragma unroll
    for (int o = 1; o < 64; o <<= 1) v += __shfl_xor(v, o);
    return v;
}
__device__ __forceinline__ float wave_max(float v) {
#pragma unroll
    for (int o = 1; o < 64; o <<= 1) v = fmaxf(v, __shfl_xor(v, o));
    return v;
}
__device__ __forceinline__ float max3f(float a, float b, float c) { float r; asm("v_max3_f32 %0, %1, %2, %3" : "=v"(r) : "v"(a), "v"(b), "v"(c)); return r; }
__device__ __forceinline__ float swap_add(float v) { auto r = __builtin_amdgcn_permlane32_swap(__float_as_uint(v), __float_as_uint(v), false, false); return __uint_as_float(r[0]) + __uint_as_float(r[1]); }
__device__ __forceinline__ float swap_max(float v) { auto r = __builtin_amdgcn_permlane32_swap(__float_as_uint(v), __float_as_uint(v), false, false); return fmaxf(__uint_as_float(r[0]), __uint_as_float(r[1])); }
typedef short v4i16_t __attribute__((ext_vector_type(4)));
__device__ __forceinline__ s16x4 vtr(LAS const unsigned char* p) { return __builtin_bit_cast(s16x4, __builtin_amdgcn_ds_read_tr16_b64_v4i16((LAS v4i16_t*)p)); }
#define MFMA32(a, b, c) __builtin_amdgcn_mfma_f32_32x32x16_bf16((a), (b), (c), 0, 0, 0)
#define MFMA16(a, b, c) __builtin_amdgcn_mfma_f32_16x16x32_bf16((a), (b), (c), 0, 0, 0)
__device__ __forceinline__ bf16x8 pack8(const f32x16& x, int s) {
    u32x4 p; p.x = cvt_pk_bf16(x[8 * s + 0], x[8 * s + 1]); p.y = cvt_pk_bf16(x[8 * s + 2], x[8 * s + 3]); p.z = cvt_pk_bf16(x[8 * s + 4], x[8 * s + 5]); p.w = cvt_pk_bf16(x[8 * s + 6], x[8 * s + 7]);
    return __builtin_bit_cast(bf16x8, p);
}
__device__ __forceinline__ bf16x8 mk_vfrag(s16x4 lo, s16x4 hi) { return (bf16x8){lo[0], lo[1], lo[2], lo[3], hi[0], hi[1], hi[2], hi[3]}; }

__device__ __forceinline__ void glds16(const void* gsrc, unsigned lds_dst) { unsigned keep;
    asm volatile("s_mov_b32 %0, m0\n\ts_mov_b32 m0, %2\n\ts_nop 0\n\tglobal_load_lds_dwordx4 %1, off\n\ts_mov_b32 m0, %0" : "=&s"(keep) : "v"(gsrc), "s"(lds_dst) : "memory"); }
template <class T> __device__ __forceinline__ T* vptr(T* p) { unsigned long long x = (unsigned long long)p; unsigned lo = (unsigned)x, hi = (unsigned)(x >> 32); asm volatile("" : "+v"(lo), "+v"(hi)); return (T*)(GAS T*)(((unsigned long long)hi << 32) | lo); }
__device__ __forceinline__ void glds16s(const void* sbase, unsigned voff, unsigned lds_dst) { unsigned keep;
    asm volatile("s_nop 4\n\ts_mov_b32 %0, m0\n\ts_mov_b32 m0, %3\n\ts_nop 0\n\tglobal_load_lds_dwordx4 %1, %2\n\ts_mov_b32 m0, %0" : "=&s"(keep) : "v"(voff), "s"(sbase), "s"(lds_dst) : "memory"); }
#define XB_TMO      128
#define XB_XCNT(j)  (256  + 64 * (j))
#define XB_XSUB(j)  (1280 + 64 * (j))
#define XB_XGEN(j)  (2304 + 64 * (j))
#define XB_TOP      3328
#define XB_TOPGEN   3392
#define XCD_BAR_WORDS 3456
#define XB_SPIN_CAP (1u << 18)

__device__ __forceinline__ unsigned xb_ld(unsigned* p)              { return __hip_atomic_load(p, __ATOMIC_RELAXED, __HIP_MEMORY_SCOPE_AGENT); }
__device__ __forceinline__ unsigned xb_add(unsigned* p, unsigned v) { return __hip_atomic_fetch_add(p, v, __ATOMIC_RELAXED, __HIP_MEMORY_SCOPE_AGENT); }
__device__ __forceinline__ unsigned xb_xcc_id() { return (unsigned)__builtin_amdgcn_s_getreg((3 << 11) | 20) & 0xFu; }
#define XB_SPIN(cond, bar) do { unsigned _sp = 0; while (cond) { __builtin_amdgcn_s_sleep(1); \
    if ((++_sp & 255u) == 0u) { if (xb_ld(&(bar)[XB_TMO])) break; if (_sp > XB_SPIN_CAP) { atomicAdd(&(bar)[XB_TMO], 1u); break; } } } } while (0)

struct XcdBarrier {
    unsigned* bar; unsigned x;
    volatile LAS unsigned* st;
};

__device__ __forceinline__ XcdBarrier xcd_barrier_post(unsigned* bar, volatile LAS unsigned* st) {
    XcdBarrier b; b.bar = bar; b.x = xb_xcc_id(); b.st = st;
    if (threadIdx.x == 0) (void)xb_add(&bar[XB_XCNT(b.x)], 1u);
    return b;
}
__device__ __forceinline__ void xcd_barrier_complete(unsigned* bar, unsigned x, unsigned& nloc, unsigned& nx) {
    const unsigned G = gridDim.x * gridDim.y * gridDim.z;
    unsigned sum, cnt, mine, sp = 0u;
    for (;;) {
        sum = 0u; cnt = 0u; mine = 0u;
#pragma unroll
        for (unsigned j = 0; j < 16; ++j) { const unsigned c = xb_ld(&bar[XB_XCNT(j)]); sum += c; cnt += (c > 0u) ? 1u : 0u; mine = (j == x) ? c : mine; }
        if (sum == G) break;
        __builtin_amdgcn_s_sleep(1);
        if ((++sp & 255u) == 0u) { if (xb_ld(&bar[XB_TMO])) break; if (sp > XB_SPIN_CAP) { atomicAdd(&bar[XB_TMO], 1u); break; } }
    }
    nloc = mine > 0u ? mine : 1u; nx = cnt > 0u ? cnt : 1u;
}

__device__ __forceinline__ void xcd_barrier(const XcdBarrier& b) {
    asm volatile("s_waitcnt vmcnt(0)" ::: "memory");
    __syncthreads();
    if (threadIdx.x == 0) {
        unsigned* bar = b.bar;
        __builtin_amdgcn_s_waitcnt(0);
        unsigned nloc = b.st[0], nx = b.st[1];
        if (nloc == 0u) { xcd_barrier_complete(bar, b.x, nloc, nx); b.st[0] = nloc; b.st[1] = nx; }
        const unsigned old = xb_add(&bar[XB_XSUB(b.x)], 1u);
        const unsigned gen = old / nloc;
        if (old + 1u == (gen + 1u) * nloc) {
            __builtin_amdgcn_fence(__ATOMIC_RELEASE, "agent");
            asm volatile("s_waitcnt vmcnt(0)" ::: "memory");
            const unsigned og = xb_add(&bar[XB_TOP], 1u);
            const unsigned tg = og / nx;
            if (og + 1u == (tg + 1u) * nx) xb_add(&bar[XB_TOPGEN], 1u);
            else XB_SPIN(xb_ld(&bar[XB_TOPGEN]) == tg, bar);
            __builtin_amdgcn_fence(__ATOMIC_ACQUIRE, "agent");
            xb_add(&bar[XB_XGEN(b.x)], 1u);
            asm volatile("s_waitcnt vmcnt(0)" ::: "memory");
        } else {
            XB_SPIN(xb_ld(&bar[XB_XGEN(b.x)]) == gen, bar);
            __builtin_amdgcn_fence(__ATOMIC_ACQUIRE, "agent");
            asm volatile("s_waitcnt vmcnt(0)" ::: "memory");
        }
    }
    __syncthreads();
}
typedef const float* cfptr_t;
typedef const cfptr_t __attribute__((address_space(4)))* kargp_t;
struct Frame {
    LAS unsigned char* lds;
    volatile LAS unsigned* MISC;
    gu32* ctl;
    int tid, lane, wave;
    int vcu, G;
    kargp_t in; float* out; unsigned char* ws;
};
#define WSP(T, off) ((T*)(F.ws + (off)))

__device__ __forceinline__ void wconv_load(const float* W, int ldw, int srccol0, const float* gain, int k0, int lane, float (&wv)[32], f32x4& g0, f32x4& g1) {
    const float* wp = W + (size_t)(k0 + (lane >> 5)) * ldw + srccol0 + (lane & 31);
#pragma unroll
    for (int i = 0; i < 32; ++i) wv[i] = wp[(size_t)(2 * i) * ldw];
    g0 = (f32x4){1.f, 1.f, 1.f, 1.f}; g1 = g0;
    if (gain) { g0 = *(const f32x4*)(gain + k0 + 8 * (lane & 7)); g1 = *(const f32x4*)(gain + k0 + 8 * (lane & 7) + 4); }
}
__device__ __forceinline__ void wconv_store(const float (&wv)[32], const f32x4 g0, const f32x4 g1, bf16_t* WT, int K, int dstrow0, int k0, LAS float* scr, int lane) {
    const int c = lane & 7;
#pragma unroll
    for (int i = 0; i < 32; ++i) scr[(2 * i + (lane >> 5)) * 33 + (lane & 31)] = wv[i];
    LDS_WAIT(); asm volatile("" ::: "memory");
#pragma unroll
    for (int j = 0; j < 4; ++j) { const int n = (lane >> 3) + 8 * j; const LAS float* s = scr + (8 * c) * 33 + n;
        u32x4 o; o.x = cvt_pk_bf16(s[0 * 33] * g0.x, s[1 * 33] * g0.y); o.y = cvt_pk_bf16(s[2 * 33] * g0.z, s[3 * 33] * g0.w); o.z = cvt_pk_bf16(s[4 * 33] * g1.x, s[5 * 33] * g1.y); o.w = cvt_pk_bf16(s[6 * 33] * g1.z, s[7 * 33] * g1.w);
        *(GAS u32x4*)(WT + (size_t)(dstrow0 + n) * K + k0 + 8 * c) = o; }
    LDS_WAIT(); asm volatile("" ::: "memory");
}
__device__ __forceinline__ void wconv_item(const float* W, int ldw, int srccol0, const float* gain, bf16_t* WT, int K, int dstrow0, int k0, LAS float* scr, int lane) {
    float wv[32]; f32x4 g0, g1; wconv_load(W, ldw, srccol0, gain, k0, lane, wv, g0, g1); wconv_store(wv, g0, g1, WT, K, dstrow0, k0, scr, lane);
}
__device__ __forceinline__ int ffn_srccol(int j0) { const int pn = j0 >> 8, jj = j0 & 255; return jj < 128 ? 128 * pn + jj : FFH + 128 * pn + (jj - 128); }
__device__ __forceinline__ float log_sigmoid(float x) { return fminf(x, 0.0f) - log1pf(expf(-fabsf(x))); }

constexpr int WC_I0 = 16 * 96, WC_I1 = 16 * 32, WC_I2 = 16 * 176, WC_I3 = 44 * 32, WC_I4 = 16 * 64, WC_I5 = 16 * 32, WC_I6 = 16 * 32, WC_I7 = WC_I2, WC_I8 = WC_I3;
constexpr int WC_LATE = WC_I1 + WC_I2 + WC_I3 + WC_I4 + WC_I5 + WC_I6 + WC_I7 + WC_I8, WC_TAIL = WC_I7 + WC_I8;
struct WcItem { const float* W; int ldw, srccol0; const float* gain; bf16_t* WT; int K, dstrow0, k0; };
__device__ __forceinline__ WcItem wc_late_item(Frame& F, int r) {
    const float* ng = F.in[7]; WcItem t;
    if (r < WC_I1) { const int kb = r / 32, nb = r % 32; t = WcItem{F.in[11], 1024, nb * 32, nullptr, WSP(bf16_t, WS_WOUT0), 1024, nb * 32, kb * 64}; return t; } r -= WC_I1;
    if (r < WC_I2) { const int kb = r / 176, nb = r % 176; t = WcItem{F.in[22], FF2, ffn_srccol(nb * 32), ng + 2 * 1024, WSP(bf16_t, WS_FIN0), 1024, nb * 32, kb * 64}; return t; } r -= WC_I2;
    if (r < WC_I3) { const int kb = r / 32, nb = r % 32; t = WcItem{F.in[23], 1024, nb * 32, nullptr, WSP(bf16_t, WS_FOUT0), FFH, nb * 32, kb * 64}; return t; } r -= WC_I3;
    if (r < WC_I4) { const int kb = r / 64, nb = r % 64; t = WcItem{F.in[13], 2048, nb * 32, F.in[12], WSP(bf16_t, WS_KVQ), 1024, nb * 32, kb * 64}; return t; } r -= WC_I4;
    if (r < WC_I5) { const int kb = r / 32, nb = r % 32; t = WcItem{F.in[15], 1024, nb * 32, ng + 4 * 1024, WSP(bf16_t, WS_KVQ), 1024, 2048 + nb * 32, kb * 64}; return t; } r -= WC_I5;
    if (r < WC_I6) { const int kb = r / 32, nb = r % 32; t = WcItem{F.in[21], 1024, nb * 32, nullptr, WSP(bf16_t, WS_WO1), 1024, nb * 32, kb * 64}; return t; } r -= WC_I6;
    if (r < WC_I7) { const int kb = r / 176, nb = r % 176; t = WcItem{F.in[22] + (size_t)1024 * FF2, FF2, ffn_srccol(nb * 32), ng + 6 * 1024, WSP(bf16_t, WS_FIN1), 1024, nb * 32, kb * 64}; return t; } r -= WC_I7;
    { const int kb = r / 32, nb = r % 32; t = WcItem{F.in[23] + (size_t)FFH * 1024, 1024, nb * 32, nullptr, WSP(bf16_t, WS_FOUT1), FFH, nb * 32, kb * 64}; return t; }
}
__device__ __forceinline__ void p0_prologue(Frame& F) {
    LAS float* scr = (LAS float*)(F.lds + F.wave * 16384);
    const int gw = F.vcu * NWAVES + F.wave, NGW = F.G * NWAVES;
    const float* ng = F.in[7];
    for (int it = gw; it < WC_I0 + (WC_LATE - WC_TAIL); it += NGW) {
        if (it < WC_I0) { const int kb = it / 96, nb = it % 96; wconv_item(F.in[8], NPROJ, nb * 32, ng, WSP(bf16_t, WS_WIN0), 1024, nb * 32, kb * 64, scr, F.lane); }
        else { const WcItem t = wc_late_item(F, it - WC_I0); wconv_item(t.W, t.ldw, t.srccol0, t.gain, t.WT, t.K, t.dstrow0, t.k0, scr, F.lane); }
    }
    __syncthreads();
    LAS float* wg = (LAS float*)F.lds;
    for (int k = F.tid; k < 1024; k += NWAVES * 64) { const float g = ng[k]; const f32x4 a = *(const f32x4*)(F.in[8] + (size_t)k * NPROJ + NP0), b = *(const f32x4*)(F.in[8] + (size_t)k * NPROJ + NP0 + 4);
        wg[0 * 1024 + k] = a[0] * g; wg[1 * 1024 + k] = a[1] * g; wg[2 * 1024 + k] = a[2] * g; wg[3 * 1024 + k] = a[3] * g;
        wg[4 * 1024 + k] = b[0] * g; wg[5 * 1024 + k] = b[1] * g; wg[6 * 1024 + k] = b[2] * g; wg[7 * 1024 + k] = b[3] * g; }
    __syncthreads();
    const int gsel = ((F.lane & 1) << 2) | (F.lane & 2) | ((F.lane >> 2) & 1);
    const float bg = F.in[9][gsel];
    bf16_t* XN = WSP(bf16_t, WS_R3); float* GT = WSP(float, WS_GATES);
    f32x4 vn[4];
#define P0_LOAD(mm) do { const float* xrow_ = (mm) < TP ? F.in[0] + (size_t)(mm) * DM : F.in[1] + (size_t)((mm) - TP) * DM; const GAS f32x4* xr_ = (const GAS f32x4*)xrow_ + F.lane; \
        _Pragma("unroll") for (int j = 0; j < 4; ++j) vn[j] = xr_[64 * j]; } while (0)
    if (gw < TT) P0_LOAD(gw);
    for (int m = gw; m < TT; m += NGW) {
        f32x4 v[4]; float s = 0.f;
#pragma unroll
        for (int j = 0; j < 4; ++j) { v[j] = vn[j]; s += (v[j].x * v[j].x + v[j].y * v[j].y) + (v[j].z * v[j].z + v[j].w * v[j].w); }
        if (m + NGW < TT) P0_LOAD(m + NGW);
        const float rstd = 1.0f / sqrtf(wave_sum(s) * (1.0f / DM) + EPS);
        GAS unsigned long long* o8 = (GAS unsigned long long*)(XN + (size_t)m * DM) + F.lane;
#pragma unroll
        for (int j = 0; j < 4; ++j) o8[64 * j] = (unsigned long long)cvt_pk_bf16(v[j].x * rstd, v[j].y * rstd) | ((unsigned long long)cvt_pk_bf16(v[j].z * rstd, v[j].w * rstd) << 32);
        float p[8];
#pragma unroll
        for (int g = 0; g < 8; ++g) { float a = 0.f;
#pragma unroll
            for (int j = 0; j < 4; ++j) { const f32x4 w = *(const LAS f32x4*)(wg + g * 1024 + 256 * j + 4 * F.lane); a += (v[j].x * w.x + v[j].y * w.y) + (v[j].z * w.z + v[j].w * w.w); }
            p[g] = a; }
        const bool b0 = F.lane & 1, b1 = F.lane & 2, b2 = F.lane & 4;
        float k4[4], k2[2], val;
#pragma unroll
        for (int i = 0; i < 4; ++i) { const float snd = b0 ? p[i] : p[i + 4]; const float rcv = __shfl_xor(snd, 1); k4[i] = (b0 ? p[i + 4] : p[i]) + rcv; }
#pragma unroll
        for (int i = 0; i < 2; ++i) { const float snd = b1 ? k4[i] : k4[i + 2]; const float rcv = __shfl_xor(snd, 2); k2[i] = (b1 ? k4[i + 2] : k4[i]) + rcv; }
        { const float snd = b2 ? k2[0] : k2[1]; const float rcv = __shfl_xor(snd, 4); val = (b2 ? k2[1] : k2[0]) + rcv; }
        val += __shfl_xor(val, 8); val += __shfl_xor(val, 16); val += __shfl_xor(val, 32);
        val = val * rstd + bg;
        if (gsel >= 4) val = log_sigmoid(val);
        if (F.lane < 8) GT[(size_t)m * 8 + gsel] = val;
    }
#undef P0_LOAD
}

template <int MODE>
__device__ __forceinline__ void norm_phase(Frame& F, const float* xin_p, const float* xin_s, const bf16_t* Gb, const float* g1) {
    const int gw = F.vcu * NWAVES + F.wave, NGW = F.G * NWAVES;
    bf16_t* XB = WSP(bf16_t, WS_XB); float* RS = WSP(float, WS_RS);
    f32x4 gv[4];
#pragma unroll
    for (int j = 0; j < 4; ++j) gv[j] = *((const f32x4*)g1 + F.lane + 64 * j);
    auto load_row = [&](int m, f32x4 (&x)[4], f32x4 (&h)[4]) {
        const GAS u32x2* gr = (const GAS u32x2*)(Gb + (size_t)m * DM) + F.lane;
        if (MODE == 0) { const float* xrow = m < TP ? xin_p + (size_t)m * DM : xin_s + (size_t)(m - TP) * DM; const GAS f32x4* xr = (const GAS f32x4*)xrow + F.lane;
#pragma unroll
            for (int j = 0; j < 4; ++j) x[j] = xr[64 * j]; }
        else { const GAS u32x2* xr = (const GAS u32x2*)(XB + (size_t)m * DM) + F.lane;
#pragma unroll
            for (int j = 0; j < 4; ++j) { const u32x2 w = xr[64 * j]; x[j] = (f32x4){bflo(w.x), bfhi(w.x), bflo(w.y), bfhi(w.y)}; } }
#pragma unroll
        for (int j = 0; j < 4; ++j) { const u32x2 w = gr[64 * j]; h[j] = (f32x4){bflo(w.x), bfhi(w.x), bflo(w.y), bfhi(w.y)}; }
    };
    auto do_row = [&](int m, f32x4 (&x)[4], f32x4 (&h)[4]) {
        float s = 0.f;
#pragma unroll
        for (int j = 0; j < 4; ++j) s += (h[j].x * h[j].x + h[j].y * h[j].y) + (h[j].z * h[j].z + h[j].w * h[j].w);
        const float r1 = 1.0f / sqrtf(wave_sum(s) * (1.0f / DM) + EPS);
#pragma unroll
        for (int j = 0; j < 4; ++j) x[j] = x[j] + h[j] * r1 * gv[j];
        if (MODE == 2) { GAS f32x4* xo = (GAS f32x4*)(F.out + (size_t)m * DM) + F.lane;
#pragma unroll
            for (int j = 0; j < 4; ++j) xo[64 * j] = x[j]; }
        else {
            unsigned long long pk[4]; float s2 = 0.f;
#pragma unroll
            for (int j = 0; j < 4; ++j) { const unsigned lo = cvt_pk_bf16(x[j].x, x[j].y), hi = cvt_pk_bf16(x[j].z, x[j].w); pk[j] = (unsigned long long)lo | ((unsigned long long)hi << 32);
                const float a = bflo(lo), b = bfhi(lo), c = bflo(hi), d = bfhi(hi); s2 += (a * a + b * b) + (c * c + d * d); }
            GAS unsigned long long* o8 = (GAS unsigned long long*)(XB + (size_t)m * DM) + F.lane;
#pragma unroll
            for (int j = 0; j < 4; ++j) o8[64 * j] = pk[j];
            const float r2 = 1.0f / sqrtf(wave_sum(s2) * (1.0f / DM) + EPS);
            if (F.lane == 0) RS[m] = r2;
        }
    };
    for (int m = gw; m < TT; m += 2 * NGW) {
        const int m1 = m + NGW; const bool two = m1 < TT;
        f32x4 xa[4], ha[4], xb[4], hb[4];
        load_row(m, xa, ha); load_row(two ? m1 : m, xb, hb);
        do_row(m, xa, ha);
        if (two) do_row(m1, xb, hb);
    }
}
template <int EPI, int K>
__device__ __forceinline__ void sgemm_phase(Frame& F, const bf16_t* A, const bf16_t* Wt, int N) {
    constexpr int KW = K / 8, STEPS = KW / 16, UN = (STEPS % 11 == 0) ? 11 : 8;
    const int tid = F.tid, lane = F.lane, w = F.wave, r32 = lane & 31, hi = lane >> 5;
    const int nct = (EPI == 2 ? FFH : N) / 32, nu = 8 * nct;
    LAS float* PART = (LAS float*)F.lds;
    for (int u = F.vcu; u < nu; u += F.G) {
        const int rt = u & 7, ct = u >> 3;
        int wr0 = 32 * ct, wr1 = 0;
        if (EPI == 2) { const int p = (32 * ct) >> 7, i = (32 * ct) & 127; wr0 = 256 * p + i; wr1 = wr0 + 128; }
        const bf16_t* ap = A + (size_t)(32 * rt + r32) * K + w * KW + 8 * hi;
        const bf16_t* b0p = Wt + (size_t)(wr0 + r32) * K + w * KW + 8 * hi; const bf16_t* b1p = Wt + (size_t)(wr1 + r32) * K + w * KW + 8 * hi;
        f32x16 acc0 = {}, acc1 = {};
#pragma unroll
        for (int s0 = 0; s0 < STEPS; s0 += UN) {
            bf16x8 av[UN], bv[UN], cv[UN];
#pragma unroll
            for (int s = 0; s < UN; ++s) { av[s] = *(const bf16x8*)(ap + 16 * (s0 + s)); bv[s] = *(const bf16x8*)(b0p + 16 * (s0 + s)); if (EPI == 2) cv[s] = *(const bf16x8*)(b1p + 16 * (s0 + s)); }
#pragma unroll
            for (int s = 0; s < UN; ++s) { acc0 = MFMA32(av[s], bv[s], acc0); if (EPI == 2) acc1 = MFMA32(av[s], cv[s], acc1); }
        }
#pragma unroll
        for (int r = 0; r < 16; ++r) { PART[(w * 32 + crow(r, hi)) * 32 + r32] = acc0[r]; if (EPI == 2) PART[8192 + (w * 32 + crow(r, hi)) * 32 + r32] = acc1[r]; }
        asm volatile("s_waitcnt lgkmcnt(0)\n\ts_barrier" ::: "memory");
        { const int row = tid >> 4, c2 = (tid & 15) * 2; f32x2 v = {0.f, 0.f}, up = {0.f, 0.f};
#pragma unroll
          for (int ww = 0; ww < 8; ++ww) { v += *(const LAS f32x2*)(PART + (ww * 32 + row) * 32 + c2); if (EPI == 2) up += *(const LAS f32x2*)(PART + 8192 + (ww * 32 + row) * 32 + c2); }
          const size_t grow = (size_t)TP + 32 * rt + row; const int c = 32 * ct + c2;
          if (EPI >= 2) { const float rsc = WSP(float, WS_RS)[grow]; v *= rsc; up *= rsc; }
          if (EPI == 0) { const int pn = c >> 8; if (pn >= 2 && pn < 4) v *= 0.08838834764831845f; if (pn >= 8) { v.x = pg8::fast_sigmoid(v.x); v.y = pg8::fast_sigmoid(v.y); }
              *(unsigned*)(WSP(bf16_t, WS_R1) + grow * NP0 + c) = cvt_pk_bf16(v.x, v.y); }
          if (EPI == 1) *(unsigned*)(WSP(bf16_t, WS_R2) + grow * DM + c) = cvt_pk_bf16(v.x, v.y);
          if (EPI == 2) *(unsigned*)(WSP(bf16_t, WS_R1) + grow * FFH + c) = cvt_pk_bf16(v.x * pg8::fast_sigmoid(v.x) * up.x, v.y * pg8::fast_sigmoid(v.y) * up.y);
          if (EPI == 3) { const size_t srow = (size_t)(32 * rt + row);
              if (c < 1024) *(f32x2*)(F.out + O_SK + srow * 1024 + c) = v; else if (c < 2048) *(f32x2*)(F.out + O_SV + srow * 1024 + (c - 1024)) = v; else v *= QSCALE;
              *(unsigned*)(WSP(bf16_t, WS_R1) + grow * 3072 + c) = cvt_pk_bf16(v.x, v.y); } }
        asm volatile("s_waitcnt lgkmcnt(0)\n\ts_barrier" ::: "memory");
    }
}

#define LBAR() asm volatile("s_waitcnt lgkmcnt(0)\n\ts_barrier" ::: "memory")
constexpr int M2_ALOG = 0, M2_AC = 16384, M2_BC = 16640, M2_MC = 16896, M2_WST = 17408, M2_WROW = 17664, M2_KT = 18432, M2_VT = 36864, M2_PITCH = 72;
__device__ __forceinline__ void m2_unit(Frame& F, int u) {
    const bool samp = u >= 256; const int uu = samp ? u - 256 : u; const int bh = uu >> 3, sl = uu & 7, b = bh >> 2, h = bh & 3;
    const int nchunk = samp ? 1 : 64, ntok = samp ? 16 : 64;
    const size_t row_base = samp ? (size_t)TP + b * 16 : (size_t)b * PSEQ;
    const int ch0 = samp ? NCH_P + bh : bh * 64;
    const float m0 = samp ? F.in[4][bh] : 0.0f;
    const int tid = F.tid, lane = F.lane, w = F.wave, fr = lane & 15, fq = lane >> 4;
    LAS float* ALOG = (LAS float*)(F.lds + M2_ALOG); LAS float* AC = (LAS float*)(F.lds + M2_AC); LAS float* BC = (LAS float*)(F.lds + M2_BC);
    LAS float* MC = (LAS float*)(F.lds + M2_MC); LAS float* WST = (LAS float*)(F.lds + M2_WST); LAS float* WROW = (LAS float*)(F.lds + M2_WROW);
    LAS bf16_t* KT = (LAS bf16_t*)(F.lds + M2_KT); LAS bf16_t* VT = (LAS bf16_t*)(F.lds + M2_VT);
    const float* GT = WSP(float, WS_GATES); float* BCUM = WSP(float, WS_BCUM); float* MST = WSP(float, WS_MST); float* NST = WSP(float, WS_NST);
    const bf16_t* P0 = WSP(bf16_t, WS_R1); bf16_t* CST = WSP(bf16_t, WS_R2);
    float igv[8], lfv[8];
#pragma unroll
    for (int i = 0; i < 8; ++i) { const int c = w + NWAVES * i; const size_t row = row_base + (size_t)(c < nchunk ? c : 0) * 64 + (lane < ntok ? lane : 0); igv[i] = GT[row * 8 + h]; lfv[i] = GT[row * 8 + 4 + h]; }
#pragma unroll
    for (int i = 0; i < 8; ++i) { const int c = w + NWAVES * i; if (c >= nchunk) break;
        const bool valid = lane < ntok; const size_t row = row_base + c * 64 + lane;
        const float ig = valid ? igv[i] : -INFINITY; const float lf = valid ? lfv[i] : 0.0f;
        float bc = lf;
#pragma unroll
        for (int o = 1; o < 64; o <<= 1) { const float t = __shfl_up(bc, o); if (lane >= o) bc += t; }
        const float Bc = __shfl(bc, 63);
        const float a = Bc - bc + ig;
        const float A = wave_max(a);
        ALOG[c * 64 + lane] = a;
        if (lane == 0) { AC[c] = A; BC[c] = Bc; }
        if (sl == 0 && valid) BCUM[row * 4 + h] = bc;
    }
    LBAR();
    if (tid == 0) { float m = m0; for (int c = 0; c < nchunk; ++c) { MC[c] = m; const float mn = fmaxf(BC[c] + m, AC[c]); WST[c] = expf(BC[c] + m - mn); m = mn; } MC[nchunk] = m; }
    LBAR();
    if (sl == 0 && tid < nchunk) MST[ch0 + tid] = MC[tid];
    f32x4 acc[2]; float nreg = 0.0f;
    if (samp) {
#pragma unroll
        for (int vh = 0; vh < 2; ++vh) acc[vh] = *(const f32x4*)(F.in[2] + ((size_t)bh * MDV + 32 * sl + 16 * vh + fr) * MDK + 16 * w + 4 * fq);
        if (tid < 128) nreg = F.in[3][bh * MDK + tid];
    } else { acc[0] = (f32x4){0.f, 0.f, 0.f, 0.f}; acc[1] = acc[0]; }
    const int st_s = tid & 63, st_c = tid >> 6;
    const int st_sc = st_s < ntok ? st_s : ntok - 1;
    const bool st_ok = st_s < ntok;
    u32x4 kA[2], vA = (u32x4){0u, 0u, 0u, 0u}, kB[2], vB = (u32x4){0u, 0u, 0u, 0u};
#define M2_LOAD(KR, VR, c) do { \
        _Pragma("unroll") for (int i_ = 0; i_ < 2; ++i_) KR[i_] = *(const u32x4*)(P0 + (row_base + (size_t)(c) * 64 + st_sc) * NP0 + 512 + h * MDK + (st_c + 8 * i_) * 8); \
        if (tid < 256) VR = *(const u32x4*)(P0 + (row_base + (size_t)(c) * 64 + st_sc) * NP0 + 1024 + h * MDV + sl * 32 + st_c * 8); } while (0)
#define M2_CHUNK(KR, VR, c) do { \
        { bf16_t* cs = CST + (size_t)(ch0 + (c)) * (MDV * MDK); \
          _Pragma("unroll") for (int vh = 0; vh < 2; ++vh) { u32x2 pk; pk.x = cvt_pk_bf16(acc[vh][0], acc[vh][1]); pk.y = cvt_pk_bf16(acc[vh][2], acc[vh][3]); \
              *(u32x2*)(cs + (32 * sl + 16 * vh + fr) * MDK + 16 * w + 4 * fq) = pk; } \
          if (sl == 0 && tid < 128) NST[(size_t)(ch0 + (c)) * MDK + tid] = nreg; } \
        LBAR();                                                  \
        const float mnext = MC[(c) + 1]; \
        _Pragma("unroll") for (int i = 0; i < 2; ++i) { \
            _Pragma("unroll") for (int e = 0; e < 8; ++e) KT[((st_c + 8 * i) * 8 + e) * M2_PITCH + st_s] = st_ok ? (bf16_t)((KR[i][e >> 1] >> ((e & 1) * 16)) & 0xffffu) : (bf16_t)0; } \
        if (tid < 256) { const float wgt = st_ok ? expf(ALOG[(c) * 64 + st_s] - mnext) : 0.0f; \
            _Pragma("unroll") for (int e = 0; e < 8; ++e) { const unsigned wd = VR[e >> 1]; const float x = (e & 1) ? bfhi(wd) : bflo(wd); VT[(st_c * 8 + e) * M2_PITCH + st_s] = st_ok ? (bf16_t)(cvt_pk_bf16(x * wgt, 0.f) & 0xffffu) : (bf16_t)0; } } \
        if (tid < 64) WROW[tid] = expf(ALOG[(c) * 64 + tid] - mnext); \
        if ((c) + 2 < nchunk) M2_LOAD(KR, VR, (c) + 2); \
        LBAR(); \
        const float wst = WST[c]; \
        acc[0] = acc[0] * wst; acc[1] = acc[1] * wst; \
        _Pragma("unroll") for (int ks = 0; ks < 2; ++ks) { const bf16x8 bk = *(const LAS bf16x8*)(KT + (16 * w + fr) * M2_PITCH + 32 * ks + 8 * fq); \
            _Pragma("unroll") for (int vh = 0; vh < 2; ++vh) { const bf16x8 av = *(const LAS bf16x8*)(VT + (16 * vh + fr) * M2_PITCH + 32 * ks + 8 * fq); acc[vh] = MFMA16(bk, av, acc[vh]); } } \
        if (sl == 0 && tid < 128) { float ns = 0.f; \
            _Pragma("unroll") for (int sb = 0; sb < 8; ++sb) { const u32x4 kk = *(const LAS u32x4*)(KT + tid * M2_PITCH + 8 * sb); const f32x4 w0 = *(const LAS f32x4*)(WROW + 8 * sb), w1 = *(const LAS f32x4*)(WROW + 8 * sb + 4); \
                ns += bflo(kk.x) * w0.x + bfhi(kk.x) * w0.y + bflo(kk.y) * w0.z + bfhi(kk.y) * w0.w + bflo(kk.z) * w1.x + bfhi(kk.z) * w1.y + bflo(kk.w) * w1.z + bfhi(kk.w) * w1.w; } \
            nreg = nreg * wst + ns; } } while (0)
    M2_LOAD(kA, vA, 0);
    if (nchunk > 1) M2_LOAD(kB, vB, 1);
    for (int c = 0; c < nchunk; c += 2) {
        M2_CHUNK(kA, vA, c);
        if (c + 1 < nchunk) M2_CHUNK(kB, vB, c + 1);
    }
#undef M2_CHUNK
#undef M2_LOAD
    { float* oc = F.out + (samp ? O_SC : O_PC) + (size_t)bh * (MDV * MDK);
#pragma unroll
      for (int vh = 0; vh < 2; ++vh) *(f32x4*)(oc + (32 * sl + 16 * vh + fr) * MDK + 16 * w + 4 * fq) = acc[vh];
      if (sl == 0 && tid < 128) F.out[(samp ? O_SN : O_PN) + bh * MDK + tid] = nreg;
      if (sl == 0 && tid == 0) F.out[(samp ? O_SM : O_PM) + bh] = MC[nchunk]; }
    LBAR();
}
__device__ __forceinline__ void m2_phase(Frame& F) { for (int u = F.vcu; u < 768; u += F.G) m2_unit(F, u); }

constexpr int M3_KL = 0, M3_VL = 16384, M3_OST = 49152, M3_OPITCH = 260, M3_SM = 116736;
__device__ __forceinline__ void m3_unit(Frame& F, int u) {
    const bool samp = u >= NCH_P; const int bh = samp ? u - NCH_P : (u >> 6), c = samp ? 0 : (u & 63), b = bh >> 2, h = bh & 3;
    const int ntok = samp ? 16 : 64; const int ch = u;
    const size_t row_base = samp ? (size_t)TP + b * 16 : (size_t)b * PSEQ + c * 64;
    const int tid = F.tid, lane = F.lane, w = F.wave, r32 = lane & 31, hi = lane >> 5;
    LAS unsigned char* KL = F.lds + M3_KL; LAS unsigned char* VL = F.lds + M3_VL; LAS float* OST = (LAS float*)(F.lds + M3_OST);
    LAS float* ES2 = (LAS float*)(F.lds + M3_SM); LAS float* ET2 = ES2 + 64; LAS float* WINT = ES2 + 128; LAS float* EMM = ES2 + 192; LAS float* N0 = ES2 + 256; LAS float* RED = ES2 + 384;
    const float* GT = vptr(WSP(float, WS_GATES)); const float* BCUM = vptr(WSP(float, WS_BCUM)); const float* MST = WSP(float, WS_MST); const float* NST = vptr(WSP(float, WS_NST));
    const bf16_t* P0 = vptr(WSP(bf16_t, WS_R1)); const bf16_t* CST = vptr(WSP(bf16_t, WS_R2) + (size_t)ch * (MDV * MDK)); bf16_t* HM = vptr(WSP(bf16_t, WS_R3));
    const int th = w & 1, vq = w >> 1; const int t = 32 * th + r32; const bool tvalid = t < ntok;
    float sc_m0 = 0.f, sc_ig = 0.f, sc_bc = 0.f;
    if (w == 0) { const size_t row = row_base + (lane < ntok ? lane : ntok - 1); sc_m0 = MST[ch]; sc_ig = GT[row * 8 + h]; sc_bc = BCUM[row * 4 + h]; }
    const u32x4 zero4 = (u32x4){0u, 0u, 0u, 0u};
    u32x4 kst[2], vst[4];
#pragma unroll
    for (int i = 0; i < 2; ++i) { const int p = tid + 512 * i, s = p >> 4, cc = p & 15; const int sc = s < ntok ? s : ntok - 1;
        kst[i] = *(const u32x4*)(P0 + (row_base + sc) * NP0 + 512 + h * MDK + cc * 8); }
#pragma unroll
    for (int i = 0; i < 4; ++i) { const int p = tid + 512 * i, s = p >> 5, c0 = (p & 31) * 8; const int sc = s < ntok ? s : ntok - 1;
        vst[i] = *(const u32x4*)(P0 + (row_base + sc) * NP0 + 1024 + h * MDV + c0); }
    bf16x8 qf[8];
    { const int tc = tvalid ? t : ntok - 1;
#pragma unroll
      for (int d0 = 0; d0 < 8; ++d0) qf[d0] = *(const bf16x8*)(P0 + (row_base + tc) * NP0 + h * MDK + 16 * d0 + 8 * hi); }
    bf16x8 cfr[2][8];
#pragma unroll
    for (int db = 0; db < 2; ++db)
#pragma unroll
        for (int st = 0; st < 8; ++st) cfr[db][st] = *(const bf16x8*)(CST + (size_t)(32 * (vq * 2 + db) + r32) * MDK + 16 * st + 8 * hi);
    if (w == 0) {
        const bool valid = lane < ntok;
        const float m0 = sc_m0; const float ig = valid ? sc_ig : -INFINITY; const float bc = sc_bc;
        const float es = ig - bc; float pm = es;
#pragma unroll
        for (int o = 1; o < 64; o <<= 1) { const float tt_ = __shfl_up(pm, o); if (lane >= o) pm = fmaxf(pm, tt_); }
        const float m = bc + fmaxf(m0, pm);
        ES2[lane] = es * LOG2E; ET2[lane] = (bc - m) * LOG2E; WINT[lane] = expf(bc + m0 - m); EMM[lane] = expf(-m);
    }
    if (tid >= 64 && tid < 192) N0[tid - 64] = NST[(size_t)ch * MDK + tid - 64];
#pragma unroll
    for (int i = 0; i < 2; ++i) { const int p = tid + 512 * i, s = p >> 4, cc = p & 15;
        *(LAS u32x4*)(KL + cc * 1024 + s * 16) = (s < ntok) ? kst[i] : zero4; }
#pragma unroll
    for (int i = 0; i < 4; ++i) { const int p = tid + 512 * i, s = p >> 5, c0 = (p & 31) * 8;
        *(LAS u32x4*)(VL + (c0 >> 5) * 4096 + (s >> 4) * 1024 + (s & 15) * 64 + (c0 & 31) * 2) = (s < ntok) ? vst[i] : zero4; }
    if (!tvalid) {
#pragma unroll
        for (int d0 = 0; d0 < 8; ++d0) qf[d0] = (bf16x8){0, 0, 0, 0, 0, 0, 0, 0}; }
    LBAR();
    const float et2 = ET2[t], wint = WINT[t], emm = EMM[t];
    f32x16 X0 = {}, X1 = {};
#pragma unroll
    for (int d0 = 0; d0 < 8; ++d0) { const bf16x8 k0 = *(const LAS bf16x8*)(KL + (2 * d0 + hi) * 1024 + r32 * 16); X0 = MFMA32(k0, qf[d0], X0);
        if (th) { const bf16x8 k1 = *(const LAS bf16x8*)(KL + (2 * d0 + hi) * 1024 + 512 + r32 * 16); X1 = MFMA32(k1, qf[d0], X1); } }
    float cs = 0.f;
#pragma unroll
    for (int r4 = 0; r4 < 4; ++r4) { const f32x4 e0 = *(const LAS f32x4*)(ES2 + 8 * r4 + 4 * hi), e1 = *(const LAS f32x4*)(ES2 + 32 + 8 * r4 + 4 * hi);
#pragma unroll
        for (int i = 0; i < 4; ++i) { const int r = 4 * r4 + i, s = 8 * r4 + 4 * hi + i;
            const float w0 = (s <= t) ? __builtin_amdgcn_exp2f(et2 + e0[i]) : 0.f; X0[r] *= w0; cs += X0[r];
            if (th) { const float w1 = (s + 32 <= t) ? __builtin_amdgcn_exp2f(et2 + e1[i]) : 0.f; X1[r] *= w1; cs += X1[r]; } } }
    cs = swap_add(cs);
    float qn = 0.f;
#pragma unroll
    for (int d0 = 0; d0 < 8; ++d0) { const f32x4 n0 = *(const LAS f32x4*)(N0 + 16 * d0 + 8 * hi), n1 = *(const LAS f32x4*)(N0 + 16 * d0 + 8 * hi + 4); const u32x4 q = __builtin_bit_cast(u32x4, qf[d0]);
        qn += bflo(q.x) * n0.x + bfhi(q.x) * n0.y + bflo(q.y) * n0.z + bfhi(q.y) * n0.w + bflo(q.z) * n1.x + bfhi(q.z) * n1.y + bflo(q.w) * n1.z + bfhi(q.w) * n1.w; }
    qn = swap_add(qn);
    const float den = wint * qn + cs; const float inv = 1.0f / fmaxf(fabsf(den), emm);
    bf16x8 pf[4]; pf[0] = pack8(X0, 0); pf[1] = pack8(X0, 1); pf[2] = pack8(X1, 0); pf[3] = pack8(X1, 1);
    LAS const unsigned char* vb0 = VL + ((lane >> 4) & 1) * 32 + (lane & 3) * 8 + (4 * hi + ((lane & 15) >> 2)) * 64;
    f32x16 o[2]; float ssq = 0.f;
#pragma unroll
    for (int db = 0; db < 2; ++db) { const int vb = vq * 2 + db; f32x16 a = {};
#pragma unroll
        for (int st = 0; st < 8; ++st) a = MFMA32(cfr[db][st], qf[st], a);
#pragma unroll
        for (int r = 0; r < 16; ++r) a[r] *= wint;
#pragma unroll
        for (int ks = 0; ks < 4; ++ks) if (ks < 2 || th) { const s16x4 lo = vtr(vb0 + vb * 4096 + ks * 1024), hh = vtr(vb0 + vb * 4096 + ks * 1024 + 512); a = MFMA32(mk_vfrag(lo, hh), pf[ks], a); }
#pragma unroll
        for (int r = 0; r < 16; ++r) { a[r] *= inv; ssq += a[r] * a[r]; }
        o[db] = a; }
    ssq = swap_add(ssq);
    if (hi == 0) RED[vq * 64 + t] = ssq;
    const float* gh = vptr(F.in[10] + h * MDV);
    u32x4 ogr[4]; f32x4 g0r[4], g1r[4];
#pragma unroll
    for (int i = 0; i < 4; ++i) { const int p = tid + 512 * i, tt = p >> 5, c8 = (p & 31) * 8; const int tc = tt < ntok ? tt : ntok - 1;
        ogr[i] = *(const u32x4*)(P0 + (row_base + tc) * NP0 + 2048 + h * MDV + c8); g0r[i] = *(const f32x4*)(gh + c8); g1r[i] = *(const f32x4*)(gh + c8 + 4); }
    LBAR();
    const float rstd = 1.0f / sqrtf((RED[t] + RED[64 + t] + RED[128 + t] + RED[192 + t]) * (1.0f / MDV) + EPS);
#pragma unroll
    for (int db = 0; db < 2; ++db)
#pragma unroll
        for (int r4 = 0; r4 < 4; ++r4) { const f32x4 v = (f32x4){o[db][4 * r4], o[db][4 * r4 + 1], o[db][4 * r4 + 2], o[db][4 * r4 + 3]} * rstd;
            *(LAS f32x4*)(OST + t * M3_OPITCH + 32 * (vq * 2 + db) + 8 * r4 + 4 * hi) = v; }
    LBAR();
#pragma unroll
    for (int i = 0; i < 4; ++i) { const int p = tid + 512 * i, tt = p >> 5, c8 = (p & 31) * 8;
        if (tt < ntok) { const f32x4 a0 = *(const LAS f32x4*)(OST + tt * M3_OPITCH + c8), a1 = *(const LAS f32x4*)(OST + tt * M3_OPITCH + c8 + 4);
            const f32x4 g0 = g0r[i], g1 = g1r[i]; const u32x4 og = ogr[i];
            u32x4 r; r.x = cvt_pk_bf16(a0.x * g0.x * bflo(og.x), a0.y * g0.y * bfhi(og.x)); r.y = cvt_pk_bf16(a0.z * g0.z * bflo(og.y), a0.w * g0.w * bfhi(og.y));
            r.z = cvt_pk_bf16(a1.x * g1.x * bflo(og.z), a1.y * g1.y * bfhi(og.z)); r.w = cvt_pk_bf16(a1.z * g1.z * bflo(og.w), a1.w * g1.w * bfhi(og.w));
            *(u32x4*)(HM + (row_base + tt) * DM + h * MDV + c8) = r; } }
    LBAR();
}
__device__ __forceinline__ void m3_phase(Frame& F) { for (int u = F.vcu; u < NCH_ALL; u += F.G) m3_unit(F, u); }

constexpr int AT_BUF = 32768, AT_K0 = 0, AT_K1 = 8192, AT_V = 16384, AT_OUTS = 65536, AT_OPITCH = 272, AT_BTAB = 131072, AT_GH = 132096, AT_LAM = 132608, AT_QL = 133120, AT_NSLOT = 4;
__device__ __forceinline__ int t5_bucket(int rel) {
    const int n = rel < 0 ? -rel : rel; const int ret = rel > 0 ? 16 : 0;
    int large = 8 + (int)(logf(fmaxf((float)n, 1.0f) * 0.125f) / logf(16.0f) * 8.0f + 1e-5f);
    large = large < 15 ? large : 15;
    return ret + (n < 8 ? n : large);
}
template <bool SAMP, int DIAG = 0>
__device__ __forceinline__ void attn_unit(Frame& F, int b, int h, int q0, float lam) {
    const int tid = F.tid, lane = F.lane, w = F.wave, r32 = lane & 31, hi = lane >> 5;
    const int j = w >> 2, qs = w & 3;
    const bf16_t* KVQ = WSP(bf16_t, WS_R1); bf16_t* AO = DIAG ? WSP(bf16_t, WS_R2) : WSP(bf16_t, WS_R3);
    const size_t rowbase = SAMP ? (size_t)TP + b * 16 : (size_t)b * PSEQ;
    const int ntile = SAMP ? 33 : (q0 >> 6) + 2;
    const int qpos0 = SAMP ? PAST : q0;
    const int nq = SAMP ? 16 : 128;
    LAS float* BTAB = (LAS float*)(F.lds + AT_BTAB); LAS float* GH = (LAS float*)(F.lds + AT_GH);
    const int rel_ = (tid & 255) - 192;
    const float bt_a = F.in[14][t5_bucket(rel_) * 8 + h], bt_b = F.in[14][15 * 8 + h];
    const float ghv = F.in[20][tid & 127];
    const int qrow = 32 * qs + r32; const bool qvalid = qrow < nq;
    bf16x8 qf[4];
#pragma unroll
    for (int d0 = 0; d0 < 4; ++d0) qf[d0] = *(const bf16x8*)(KVQ + (rowbase + q0 + (qvalid ? qrow : 0)) * 3072 + 2048 + h * 128 + j * 64 + 16 * d0 + 8 * hi);
    const unsigned dko = (unsigned)(((rowbase + 8 * w + (lane >> 3)) * 3072 + h * 128 + (((lane & 7) ^ (((8 * w + (lane >> 3)) >> 1) & 7)) * 8)) * 2);
    const unsigned dvo = (unsigned)(((rowbase + 16 * ((2 * w) & 3) + (lane >> 2)) * 3072 + 1024 + h * 128 + ((2 * w) >> 2) * 32 + (lane & 3) * 8) * 2);
    const unsigned lds0 = (unsigned)(uintptr_t)F.lds;
#define AT_DMA(kt, slot) do { const char* tb_ = (const char*)KVQ + (size_t)(kt) * (64 * 3072 * 2); const unsigned B_ = lds0 + (slot) * AT_BUF; \
        glds16s(tb_, dko, (unsigned)__builtin_amdgcn_readfirstlane(B_ + AT_K0 + w * 1024)); \
        glds16s(tb_ + 128, dko, (unsigned)__builtin_amdgcn_readfirstlane(B_ + AT_K1 + w * 1024)); \
        glds16s(tb_, dvo, (unsigned)__builtin_amdgcn_readfirstlane(B_ + AT_V + (2 * w) * 1024)); \
        glds16s(tb_ + 16 * 3072 * 2, dvo, (unsigned)__builtin_amdgcn_readfirstlane(B_ + AT_V + (2 * w + 1) * 1024)); } while (0)
    if (!SAMP && !(DIAG & 1)) { AT_DMA(0, 0); AT_DMA(1, 1); }
    if (tid < 256) BTAB[tid] = (bt_a - bt_b) * LOG2E;
    if (tid >= 256 && tid < 384) GH[tid - 256] = ghv;
    if (!qvalid) { qf[0] = (bf16x8){0, 0, 0, 0, 0, 0, 0, 0}; qf[1] = qf[0]; qf[2] = qf[0]; qf[3] = qf[0]; }
    LAS unsigned char* qlane = F.lds + AT_QL + w * 3072 + lane * 16;
    *(LAS bf16x8*)qlane = qf[1]; *(LAS bf16x8*)(qlane + 1024) = qf[2]; *(LAS bf16x8*)(qlane + 2048) = qf[3];
    const int qpos = qpos0 + qrow;
    const int cq = SAMP ? 32 : ((q0 + 32 * qs) >> 6);
    const bool wactive = SAMP ? (qs == 0) : true;
    const float* ck = F.in[5]; const float* cv = F.in[6]; const float* nk = F.out + O_SK; const float* nv = F.out + O_SV;
    const int lt = ((w & 3) - 1 + 3 * (w >> 2)) * 64 + lane;
#define AT_SLOAD(kt, slot) do { LAS unsigned char* B_ = F.lds + (slot) * AT_BUF; f32x4 fa[6], fb[6]; \
        _Pragma("unroll") for (int i_ = 0; i_ < 6; ++i_) { int p_ = lt + 384 * i_; p_ = p_ < 2048 ? p_ : 2047; const int row_ = p_ >> 5, c_ = p_ & 31; int kv_ = (kt) * 64 + row_; kv_ = kv_ < PAST + 16 ? kv_ : PAST + 15; \
            const float* src_ = (c_ < 16) ? (kv_ < PAST ? ck + ((size_t)b * PAST + kv_) * 1024 : nk + ((size_t)b * 16 + (kv_ - PAST)) * 1024) + h * 128 + c_ * 8 \
                                          : (kv_ < PAST ? cv + ((size_t)b * PAST + kv_) * 1024 : nv + ((size_t)b * 16 + (kv_ - PAST)) * 1024) + h * 128 + (c_ - 16) * 8; \
            fa[i_] = *(const f32x4*)src_; fb[i_] = *(const f32x4*)(src_ + 4); } \
        _Pragma("unroll") for (int i_ = 0; i_ < 6; ++i_) { const int p_ = lt + 384 * i_; const int row_ = (p_ >> 5) & 63, c_ = p_ & 31; \
            const int off_ = (c_ < 8) ? AT_K0 + row_ * 128 + ((c_ ^ ((row_ >> 1) & 7)) * 16) : (c_ < 16) ? AT_K1 + row_ * 128 + (((c_ - 8) ^ ((row_ >> 1) & 7)) * 16) : AT_V + ((c_ - 16) >> 2) * 4096 + (row_ >> 4) * 1024 + (row_ & 15) * 64 + ((c_ - 16) & 3) * 16; \
            const u32x4 v_ = (u32x4){cvt_pk_bf16(fa[i_].x, fa[i_].y), cvt_pk_bf16(fa[i_].z, fa[i_].w), cvt_pk_bf16(fb[i_].x, fb[i_].y), cvt_pk_bf16(fb[i_].z, fb[i_].w)}; \
            if (p_ < 2048) *(LAS u32x4*)(B_ + off_) = v_; } } while (0)
    if (SAMP && qs != 0) {
        AT_SLOAD(0, 0);
        __syncthreads();
        int sl = 0;
        for (int kt = 0; kt < ntile; ++kt) { const int sln = (sl + 1) & 3; if (kt + 1 < ntile) AT_SLOAD(kt + 1, sln); __syncthreads(); sl = sln; }
        __syncthreads(); __syncthreads();
    } else {
    f32x16 o[4]; o[0] = f32x16{}; o[1] = f32x16{}; o[2] = f32x16{}; o[3] = f32x16{};
    float mrun = -INFINITY, lrun = 0.f;
    bf16x8 pf[4];
    const int qmin = qpos0 + 32 * qs;
    LAS const unsigned char* vlane = F.lds + AT_V + ((lane >> 4) & 1) * 32 + (lane & 3) * 8 + (4 * hi + ((lane & 15) >> 2)) * 64;
    LAS const unsigned char* klane = F.lds + (j ? AT_K1 : AT_K0) + r32 * 128; const int kswz = (r32 >> 1) & 7;
    int kofs[4];
#pragma unroll
    for (int d0 = 0; d0 < 4; ++d0) kofs[d0] = ((2 * d0 + hi) ^ kswz) * 16;
#define TRR(dst, addr, off) asm volatile("ds_read_b64_tr_b16 %0, %1 offset:%c2" : "=&v"(dst) : "v"(addr), "i"(off) : "memory")
#define AT_VRD(V, db) do { _Pragma("unroll") for (int ks_ = 0; ks_ < 4; ++ks_) { TRR(V[2 * ks_], vaddr, (db) * 4096 + ks_ * 1024); TRR(V[2 * ks_ + 1], vaddr, (db) * 4096 + ks_ * 1024 + 512); } } while (0)
#define AT_EXP2(P, a) do { if (WE_ && !(DIAG & 8)) { P[a] = __builtin_amdgcn_exp2f(P[a] - mnew); P[(a) + 1] = __builtin_amdgcn_exp2f(P[(a) + 1] - mnew); asm volatile("" : "+v"(P[a]), "+v"(P[(a) + 1])); } } while (0)
#define AT_PVBLK(db, V, P, a) do { \
        o[db] = MFMA32(mk_vfrag(V[0], V[1]), pf[0], o[db]); AT_EXP2(P, a); __builtin_amdgcn_sched_barrier(0); \
        o[db] = MFMA32(mk_vfrag(V[2], V[3]), pf[1], o[db]); AT_EXP2(P, (a) + 2); __builtin_amdgcn_sched_barrier(0); \
        o[db] = MFMA32(mk_vfrag(V[4], V[5]), pf[2], o[db]); AT_EXP2(P, (a) + 4); __builtin_amdgcn_sched_barrier(0); \
        o[db] = MFMA32(mk_vfrag(V[6], V[7]), pf[3], o[db]); AT_EXP2(P, (a) + 6); __builtin_amdgcn_sched_barrier(0); } while (0)
#define AT_STEP(kt, slk, slv, DO_QK, DO_PV) do { constexpr bool WE_ = DO_QK; \
        f32x16 X0 = {}, X1 = {}; bool need = false; float alpha = 1.0f, mnew = mrun; \
        if (DO_QK) { LAS const unsigned char* KB_ = klane + (slk) * AT_BUF; \
            _Pragma("unroll") for (int d0 = 0; d0 < 4; ++d0) { const int ko_ = kofs[d0]; const bf16x8 k0 = *(const LAS bf16x8*)(KB_ + ko_), k1 = *(const LAS bf16x8*)(KB_ + ko_ + 4096); \
                const bf16x8 qd = d0 == 0 ? qf[0] : *(const LAS bf16x8*)(qlane + (d0 - 1) * 1024); X0 = MFMA32(k0, qd, X0); X1 = MFMA32(k1, qd, X1); } \
            asm volatile("s_nop 15\n\ts_nop 7" : "+v"(X0), "+v"(X1));        \
            if ((kt) * 64 + 63 + 91 > qmin) { const int base = (kt) * 64 + 4 * hi - qpos + 192;        \
                _Pragma("unroll") for (int r = 0; r < 16; ++r) { X0[r] += BTAB[base + (r & 3) + 8 * (r >> 2)]; X1[r] += BTAB[base + (r & 3) + 8 * (r >> 2) + 32]; } } \
            if (SAMP && (kt) == 32) { _Pragma("unroll") for (int r = 0; r < 16; ++r) { if (crow(r, hi) >= 16) X0[r] = -INFINITY; X1[r] = -INFINITY; } } \
            if ((kt) > cq) { _Pragma("unroll") for (int r = 0; r < 16; ++r) { X0[r] = -INFINITY; X1[r] = -INFINITY; } }        \
            float ma = max3f(X0[0], X0[1], X1[0]), mb = max3f(X0[2], X0[3], X1[1]); ma = max3f(ma, X1[2], X1[3]); \
            _Pragma("unroll") for (int r = 4; r < 16; r += 4) { ma = max3f(ma, X0[r], X0[r + 1]); mb = max3f(mb, X0[r + 2], X0[r + 3]); ma = max3f(ma, X1[r], X1[r + 1]); mb = max3f(mb, X1[r + 2], X1[r + 3]); } \
            float mx = max3f(ma, mb, mb); mx = swap_max(mx); \
            need = __any(mx > mrun + 8.0f) != 0; \
            mnew = need ? fmaxf(mrun, mx) : mrun; alpha = __builtin_amdgcn_exp2f(mrun - mnew); mrun = mnew; } \
        __builtin_amdgcn_sched_barrier(0); \
        if (DO_PV) { const unsigned vaddr = (unsigned)(uintptr_t)(vlane + (slv) * AT_BUF); s16x4 va[8], vb[8]; \
            AT_VRD(va, 0); AT_VRD(vb, 1); asm volatile("s_waitcnt lgkmcnt(8)" ::: "memory"); __builtin_amdgcn_sched_barrier(0); \
            AT_PVBLK(0, va, X0, 0); \
            AT_VRD(va, 2); asm volatile("s_waitcnt lgkmcnt(8)" ::: "memory"); __builtin_amdgcn_sched_barrier(0); \
            AT_PVBLK(1, vb, X0, 8); \
            AT_VRD(vb, 3); asm volatile("s_waitcnt lgkmcnt(8)" ::: "memory"); __builtin_amdgcn_sched_barrier(0); \
            AT_PVBLK(2, va, X1, 0); \
            asm volatile("s_waitcnt lgkmcnt(0)" ::: "memory"); __builtin_amdgcn_sched_barrier(0); \
            AT_PVBLK(3, vb, X1, 8); } \
        else if (DO_QK) { _Pragma("unroll") for (int r = 0; r < 16; ++r) { X0[r] = __builtin_amdgcn_exp2f(X0[r] - mnew); X1[r] = __builtin_amdgcn_exp2f(X1[r] - mnew); } } \
        if (DO_QK) { if (need) { _Pragma("unroll") for (int db = 0; db < 4; ++db) _Pragma("unroll") for (int r = 0; r < 16; ++r) o[db][r] *= alpha; } \
            float ps = 0.f; _Pragma("unroll") for (int r = 0; r < 16; ++r) ps += X0[r] + X1[r]; \
            lrun = lrun * alpha + ps; pf[0] = pack8(X0, 0); pf[1] = pack8(X0, 1); pf[2] = pack8(X1, 0); pf[3] = pack8(X1, 1); } } while (0)
    f32x16 X0 = {}, X1 = {}; bool need = false; float alpha = 1.0f, mnew = -INFINITY;
#define AT_SUMPACK() do { float pa_ = X0[0] + X1[0], pb_ = X0[1] + X1[1], pc_ = X0[2] + X1[2], pd_ = X0[3] + X1[3]; \
        _Pragma("unroll") for (int r = 4; r < 16; r += 4) { pa_ += X0[r] + X1[r]; pb_ += X0[r + 1] + X1[r + 1]; pc_ += X0[r + 2] + X1[r + 2]; pd_ += X0[r + 3] + X1[r + 3]; } lrun += (pa_ + pb_) + (pc_ + pd_); \
        pf[0] = pack8(X0, 0); pf[1] = pack8(X0, 1); pf[2] = pack8(X1, 0); pf[3] = pack8(X1, 1); } while (0)
#define AT_H1(kt, slk, HASPREV) do { if (HASPREV && !(DIAG & 16)) AT_SUMPACK(); \
        { LAS const unsigned char* KB_ = klane + (slk) * AT_BUF; X0 = f32x16{}; X1 = f32x16{}; \
            _Pragma("unroll") for (int d0 = 0; d0 < 4; ++d0) { const int ko_ = kofs[d0]; const bf16x8 k0 = *(const LAS bf16x8*)(KB_ + ko_), k1 = *(const LAS bf16x8*)(KB_ + ko_ + 4096); \
                const bf16x8 qd = d0 == 0 ? qf[0] : *(const LAS bf16x8*)(qlane + (d0 - 1) * 1024); X0 = MFMA32(k0, qd, X0); X1 = MFMA32(k1, qd, X1); } \
            asm volatile("s_nop 15\n\ts_nop 7" : "+v"(X0), "+v"(X1)); \
            if ((kt) * 64 + 63 + 91 > qmin) { const int base = (kt) * 64 + 4 * hi - qpos + 192; \
                _Pragma("unroll") for (int r = 0; r < 16; ++r) { X0[r] += BTAB[base + (r & 3) + 8 * (r >> 2)]; X1[r] += BTAB[base + (r & 3) + 8 * (r >> 2) + 32]; } } \
            if (__builtin_expect((kt) > cq, 0)) { asm volatile("; tile not visible to this wave" ::: "memory"); _Pragma("unroll") for (int r = 0; r < 16; ++r) { X0[r] = -INFINITY; X1[r] = -INFINITY; } } \
            float ma = max3f(X0[0], X0[1], X1[0]), mb = max3f(X0[2], X0[3], X1[1]); ma = max3f(ma, X1[2], X1[3]); \
            _Pragma("unroll") for (int r = 4; r < 16; r += 4) { ma = max3f(ma, X0[r], X0[r + 1]); mb = max3f(mb, X0[r + 2], X0[r + 3]); ma = max3f(ma, X1[r], X1[r + 1]); mb = max3f(mb, X1[r + 2], X1[r + 3]); } \
            float mx = max3f(ma, mb, mb); mx = swap_max(mx); \
            need = __any(mx > mrun + 8.0f) != 0; \
            mnew = need ? fmaxf(mrun, mx) : mrun; alpha = __builtin_amdgcn_exp2f(mrun - mnew); mrun = mnew; } } while (0)
#define AT_PV4(slv, WE) do { constexpr bool WE_ = WE; const unsigned vaddr = (unsigned)(uintptr_t)(vlane + (slv) * AT_BUF); s16x4 va[8], vb[8]; \
            AT_VRD(va, 0); AT_VRD(vb, 1); asm volatile("s_waitcnt lgkmcnt(8)" ::: "memory"); __builtin_amdgcn_sched_barrier(0); \
            AT_PVBLK(0, va, X0, 0); \
            AT_VRD(va, 2); asm volatile("s_waitcnt lgkmcnt(8)" ::: "memory"); __builtin_amdgcn_sched_barrier(0); \
            AT_PVBLK(1, vb, X0, 8); \
            AT_VRD(vb, 3); asm volatile("s_waitcnt lgkmcnt(8)" ::: "memory"); __builtin_amdgcn_sched_barrier(0); \
            AT_PVBLK(2, va, X1, 0); \
            asm volatile("s_waitcnt lgkmcnt(0)" ::: "memory"); __builtin_amdgcn_sched_barrier(0); \
            AT_PVBLK(3, vb, X1, 8); } while (0)
#define AT_H2(slv, HASPREV) do { if (HASPREV && !(DIAG & 4)) AT_PV4(slv, true); \
        else { _Pragma("unroll") for (int r = 0; r < 16; ++r) { X0[r] = __builtin_amdgcn_exp2f(X0[r] - mnew); X1[r] = __builtin_amdgcn_exp2f(X1[r] - mnew); } } \
        if (need) { _Pragma("unroll") for (int db = 0; db < 4; ++db) _Pragma("unroll") for (int r = 0; r < 16; ++r) o[db][r] *= alpha; } \
        lrun *= alpha; } while (0)
#define AT_FIN(slv) do { AT_SUMPACK(); if (!(DIAG & 4)) AT_PV4(slv, false); } while (0)
#define AT_WAITBAR(N) asm volatile("s_waitcnt vmcnt(" #N ") lgkmcnt(0)\n\ts_barrier" ::: "memory")
    if (SAMP) {
        __syncthreads();
        int sl = 0;
        for (int kt = 0; kt < ntile; ++kt) {
            const int slp = (sl + 3) & 3;
            if (kt == 0) AT_STEP(kt, sl, slp, true, false); else AT_STEP(kt, sl, slp, true, true);
            __syncthreads();
            sl = (sl + 1) & 3;
        }
        { const int sll = (sl + 3) & 3; AT_STEP(0, 0, sll, false, true); }
    } else {
        AT_WAITBAR(4);
#define AT_BAR() asm volatile("s_waitcnt lgkmcnt(0)\n\ts_barrier" ::: "memory")
        if (j) AT_BAR();
        if (!(DIAG & 2)) AT_H1(0, 0, false);
        AT_WAITBAR(0);
        if (!(DIAG & 1) && ntile > 2) AT_DMA(2, 2);
        if (!(DIAG & 2)) AT_H2(3, false);
        AT_BAR();
        for (int t = 1; t < ntile; ++t) {
            if (!(DIAG & 2)) AT_H1(t, t & 3, true);
            AT_WAITBAR(0);
            if (!(DIAG & 1) && t + 2 < ntile) AT_DMA(t + 2, (t + 2) & 3);
            if (!(DIAG & 2)) AT_H2((t + 3) & 3, true);
            AT_BAR();
        }
        if (!(DIAG & 2)) AT_FIN((ntile + 3) & 3);
        if (!j) AT_BAR();
#undef AT_BAR
    }
#undef AT_WAITBAR
#undef AT_DMA
#undef AT_STEP
#undef AT_H1
#undef AT_H2
#undef AT_FIN
#undef AT_PV4
#undef AT_SUMPACK
#undef AT_PVBLK
#undef AT_EXP2
#undef AT_VRD
#undef TRR
#undef AT_STAGE
#undef AT_DMA
#undef AT_SLOAD
#undef AT_DMA
    const float inv = 1.0f / swap_add(lrun);
    __syncthreads();
    LAS float* STG = (LAS float*)F.lds;
    if (j == 1) {
        const float f = -lam * inv;
#pragma unroll
        for (int db = 0; db < 4; ++db)
#pragma unroll
            for (int r = 0; r < 16; ++r) STG[(qs * 64 + db * 16 + r) * 64 + lane] = o[db][r] * f;
    }
    __syncthreads();
    if (j == 0) {
        float ssq = 0.f;
#pragma unroll
        for (int db = 0; db < 4; ++db)
#pragma unroll
            for (int r = 0; r < 16; ++r) { const float v = o[db][r] * inv + STG[(qs * 64 + db * 16 + r) * 64 + lane]; o[db][r] = v; ssq += v * v; }
        ssq = swap_add(ssq);
        const float rs = (1.0f - LAM_INIT) / sqrtf(ssq * (1.0f / 128.0f) + EPS);
        int dl = 4 * hi; asm volatile("" : "+v"(dl));
        LAS const float* ghp = GH + dl; LAS unsigned char* outp = F.lds + AT_OUTS + (32 * qs + r32) * AT_OPITCH + dl * 2;
#pragma unroll
        for (int db = 0; db < 4; ++db)
#pragma unroll
            for (int r4 = 0; r4 < 4; ++r4) { const f32x4 g = *(const LAS f32x4*)(ghp + 32 * db + 8 * r4);
                u32x2 pk; pk.x = cvt_pk_bf16(o[db][4 * r4] * rs * g.x, o[db][4 * r4 + 1] * rs * g.y); pk.y = cvt_pk_bf16(o[db][4 * r4 + 2] * rs * g.z, o[db][4 * r4 + 3] * rs * g.w);
                *(LAS u32x2*)(outp + (32 * db + 8 * r4) * 2) = pk; }
    }
    }
    __syncthreads();
    { LAS const unsigned char* OUTS = F.lds + AT_OUTS;
#pragma unroll
      for (int i = 0; i < 4; ++i) { const int p = tid + 512 * i, tt = p >> 4, c8 = (p & 15) * 8;
          if (tt < nq) *(u32x4*)(AO + (rowbase + q0 + tt) * DM + h * 128 + c8) = *(const LAS u32x4*)(OUTS + tt * AT_OPITCH + c8 * 2); } }
    if (!SAMP && DIAG == 0) {
        float* pk = F.out + O_PK + ((size_t)b * PSEQ + q0) * 1024 + h * 128; float* pv = F.out + O_PV + ((size_t)b * PSEQ + q0) * 1024 + h * 128;
        const bf16_t* src = KVQ + (rowbase + q0) * 3072 + h * 128;
#pragma unroll 1
        for (int i = 0; i < 8; ++i) { int p = tid + 512 * i; asm volatile("" : "+v"(p)); const int row = p >> 5, c = p & 31;
            const u32x4 wv = *(const u32x4*)(src + (size_t)row * 3072 + (c < 16 ? c * 8 : 1024 + (c - 16) * 8));
            float* d = (c < 16 ? pk + c * 8 : pv + (c - 16) * 8) + (size_t)row * 1024;
            *(f32x4*)d = (f32x4){bflo(wv.x), bfhi(wv.x), bflo(wv.y), bfhi(wv.y)}; *(f32x4*)(d + 4) = (f32x4){bflo(wv.z), bfhi(wv.z), bflo(wv.w), bfhi(wv.w)}; }
    }
    __syncthreads();
}
__device__ __forceinline__ void attn_phase(Frame& F, bool do_prompt, bool do_sample) {
    LAS float* LAMW = (LAS float*)(F.lds + AT_LAM);
    if (F.wave == 0) { const float s1 = wave_sum(F.in[16][F.lane] * F.in[17][F.lane]), s2 = wave_sum(F.in[18][F.lane] * F.in[19][F.lane]);
        if (F.lane == 0) LAMW[0] = expf(s1) - expf(s2) + LAM_INIT; }
    __syncthreads();
    const float lam = LAMW[0];
    if (do_prompt)
    for (int v = F.vcu; v < 256; v += F.G) { const int x = v >> 5, i = v & 31;
        for (int r = 0; r < 8; ++r) { const int bh = 8 * x + r, qb = (r & 1) ? 31 - i : i; attn_unit<false>(F, bh >> 3, bh & 7, qb * 128, lam); } }
    if (do_prompt && F.G == 256 && F.vcu >= 128) {
        unsigned* gcnt = (unsigned*)(F.ctl + CW_GRP + 64 * (F.vcu >> 5)); unsigned* gbar = (unsigned*)(F.ctl + CW_BAR);
        asm volatile("s_waitcnt vmcnt(0)" ::: "memory");
        __syncthreads();
        if (F.tid == 0) {
            __builtin_amdgcn_fence(__ATOMIC_RELEASE, "agent"); asm volatile("s_waitcnt vmcnt(0)" ::: "memory");
            (void)xb_add(gcnt, 1u); XB_SPIN(xb_ld(gcnt) < 32u, gbar);
            __builtin_amdgcn_fence(__ATOMIC_ACQUIRE, "agent"); asm volatile("s_waitcnt vmcnt(0)" ::: "memory");
        }
        __syncthreads();
        pg8::Gemm g{WSP(bf16_t, WS_R3), WSP(bf16_t, WS_WO1), TP, 1024, 1024}; pg8::SubOrder S; S.S.init(TP, 1024, F.G, (int)blockIdx.x); S.i0 = 0; S.n = 2;
        pg8::EpiBf16T E{WSP(bf16_t, WS_R2), 1024, 0, 0, 1.0f, 1 << 30};
        pg8::gemm_phase<pg8::EpiBf16T, pg8::SubOrder, true, true>(F.lds, g, S, E);
        __syncthreads();
    }
    if (do_prompt) {
        const bool all = F.G < 256; const int wk = all ? F.vcu : F.vcu - 128, nwk = all ? F.G : 128;
        if (all || (F.vcu >= 128 && F.vcu < 256)) { LAS float* scr = (LAS float*)(F.lds + F.wave * 16384);
            for (int r = (WC_LATE - WC_TAIL) + wk * NWAVES + F.wave; r < WC_LATE; r += nwk * NWAVES) { const WcItem t = wc_late_item(F, r); wconv_item(t.W, t.ldw, t.srccol0, t.gain, t.WT, t.K, t.dstrow0, t.k0, scr, F.lane); } }
    }
    if (do_sample)
    for (int v = F.vcu; v < 128; v += F.G) attn_unit<true>(F, v >> 3, v & 7, 0, lam);
}
#ifdef DIAGV
__device__ __forceinline__ void attn_phase_diag(Frame& F) {
    for (int v = F.vcu; v < 256; v += F.G) { const int x = v >> 5, i = v & 31;
        for (int r = 0; r < 8; ++r) { const int bh = 8 * x + r, qb = (r & 1) ? 31 - i : i; attn_unit<false, DIAGV>(F, bh >> 3, bh & 7, qb * 128, 0.5f); } }
}
#endif
constexpr int N_PHASES = 16;
struct Args { const float* in[24]; float* out; unsigned char* ws; int ph_lo, ph_hi; };
__global__ void __launch_bounds__(NWAVES * 64, 2) mk_fwd(Args args) {
    extern __shared__ __attribute__((aligned(16))) unsigned char lds[];
    Frame F;
    F.lds = (LAS unsigned char*)lds;
    F.MISC = (volatile LAS unsigned*)(F.lds + MISC_OFF);
    F.tid = threadIdx.x; F.lane = F.tid & 63; F.wave = __builtin_amdgcn_readfirstlane(F.tid >> 6);
    F.G = gridDim.x; { const int bx = blockIdx.x; F.vcu = (F.G % 8 == 0) ? (bx % 8) * (F.G / 8) + bx / 8 : bx; }
    F.in = (kargp_t)args.in;
    F.out = args.out; F.ws = args.ws; F.ctl = (gu32*)(args.ws + WS_CTL);
    for (int u = F.tid; u < (LDS_BYTES - LDSCTL_OFF) / 4; u += NWAVES * 64) ((LAS unsigned*)(F.lds + LDSCTL_OFF))[u] = 0u;
    __syncthreads();
    XcdBarrier bar; bar.bar = (unsigned*)(F.ctl + CW_BAR); bar.x = 0; bar.st = nullptr;
    if (MK_N_LAUNCHES == 1) bar = xcd_barrier_post((unsigned*)(F.ctl + CW_BAR), F.MISC + 8);
    const int lo = args.ph_lo, hi = args.ph_hi;
#ifndef PH_MASK
#define PH_MASK 0x7ffff
#endif
#define IN(k) (((PH_MASK >> (k)) & 1) && lo <= (k) && (k) < hi)
#define SEAM(k) do { if (IN(k) && IN((k) + 1)) xcd_barrier(bar); { unsigned z_; asm volatile("s_mov_b32 %0, 0" : "=s"(z_)); F.ws = args.ws + z_; F.out = args.out + z_; F.in = (kargp_t)args.in + z_; } } while (0)
#define B_XN WSP(bf16_t, WS_R3)
#define B_R1 WSP(bf16_t, WS_R1)
#define B_G WSP(bf16_t, WS_R2)
#define P_NG (F.in[7])
    const int bx = (int)blockIdx.x;
    if (IN(0)) { p0_prologue(F); } SEAM(0);
    if (IN(1)) { pg8::Gemm g{B_XN, WSP(bf16_t, WS_WIN0), TP, NP0, 1024}; pg8::StaticOrder S; S.init(TP, NP0, F.G, bx);
        pg8::EpiBf16T E{B_R1, NP0, 2, 4, 0.08838834764831845f, 8};
        pg8::gemm_phase<pg8::EpiBf16T, pg8::StaticOrder, true, true>(F.lds, g, S, E);
        sgemm_phase<0, 1024>(F, B_XN + (size_t)TP * DM, WSP(bf16_t, WS_WIN0), NP0); } SEAM(1);
    if (IN(2)) { m2_phase(F); } SEAM(2);
    if (IN(3)) { m3_phase(F); } SEAM(3);
    if (IN(4)) { pg8::Gemm g{B_XN, WSP(bf16_t, WS_WOUT0), TP, 1024, 1024}; pg8::StaticOrder S; S.init(TP, 1024, F.G, bx);
        pg8::EpiBf16T E{B_G, 1024, 0, 0, 1.0f, 1 << 30};
        pg8::gemm_phase<pg8::EpiBf16T, pg8::StaticOrder, true, true>(F.lds, g, S, E);
        sgemm_phase<1, 1024>(F, B_XN + (size_t)TP * DM, WSP(bf16_t, WS_WOUT0), 1024); } SEAM(4);
    if (IN(5)) { norm_phase<0>(F, F.in[0], F.in[1], B_G, P_NG + 1 * 1024); } SEAM(5);
    if (IN(6)) { pg8::Gemm g{WSP(bf16_t, WS_XB), WSP(bf16_t, WS_FIN0), TP, FF2, 1024}; pg8::StaticOrder S; S.init(TP, FF2, F.G, bx);
        pg8::EpiSwiglu E{B_R1, FFH, WSP(float, WS_RS)};
        pg8::gemm_phase<pg8::EpiSwiglu, pg8::StaticOrder, true, true>(F.lds, g, S, E);
        sgemm_phase<2, 1024>(F, WSP(bf16_t, WS_XB) + (size_t)TP * DM, WSP(bf16_t, WS_FIN0), FF2); } SEAM(6);
    if (IN(7)) { pg8::Gemm g{B_R1, WSP(bf16_t, WS_FOUT0), TP, 1024, FFH}; pg8::StaticOrder S; S.init(TP, 1024, F.G, bx);
        pg8::EpiBf16T E{B_G, 1024, 0, 0, 1.0f, 1 << 30};
        pg8::gemm_phase<pg8::EpiBf16T, pg8::StaticOrder, true, true>(F.lds, g, S, E);
        sgemm_phase<1, FFH>(F, B_R1 + (size_t)TP * FFH, WSP(bf16_t, WS_FOUT0), 1024); } SEAM(7);
    if (IN(8)) { norm_phase<1>(F, nullptr, nullptr, B_G, P_NG + 3 * 1024); } SEAM(8);
    if (IN(9)) { pg8::Gemm g{WSP(bf16_t, WS_XB), WSP(bf16_t, WS_KVQ), TP, 3072, 1024}; pg8::StaticOrder S; S.init(TP, 3072, F.G, bx);
        pg8::EpiKVQ E{B_R1, F.out, QSCALE, WSP(float, WS_RS)};
        pg8::gemm_phase<pg8::EpiKVQ, pg8::StaticOrder, true, true>(F.lds, g, S, E);
        sgemm_phase<3, 1024>(F, WSP(bf16_t, WS_XB) + (size_t)TP * DM, WSP(bf16_t, WS_KVQ), 3072); } SEAM(9);
    if (IN(10)) { attn_phase(F, true, MK_N_LAUNCHES == 1); } SEAM(10);
    if (MK_N_LAUNCHES != 1 && IN(16)) { attn_phase(F, false, true); }
#ifdef DIAGV
    if (MK_N_LAUNCHES != 1 && IN(17)) { attn_phase_diag(F); }
#endif
#ifdef GDIAG
    if (MK_N_LAUNCHES != 1 && IN(18)) { pg8::Gemm g{WSP(bf16_t, WS_XB), WSP(bf16_t, WS_FIN0), TP, FF2, 1024}; pg8::StaticOrder S; S.init(TP, FF2, F.G, bx);
        pg8::EpiSwiglu E{B_R1, FFH, WSP(float, WS_RS)};
        pg8::gemm_phase<pg8::EpiSwiglu, pg8::StaticOrder, true, true, GDIAG>(F.lds, g, S, E); }
#endif
    if (IN(11)) { pg8::Gemm g{B_XN, WSP(bf16_t, WS_WO1), TP, 1024, 1024};
        pg8::SubOrder S; const int grp = bx & 7;
        if (F.G == 256) { S.S.init(TP, 1024, F.G, grp < 4 ? bx : bx - 4); S.i0 = grp < 4 ? 0 : 1; S.n = 1; } else { S.S.init(TP, 1024, F.G, bx); S.i0 = 0; S.n = 1 << 30; }
        pg8::EpiBf16T E{B_G, 1024, 0, 0, 1.0f, 1 << 30};
        pg8::gemm_phase<pg8::EpiBf16T, pg8::SubOrder, true, true>(F.lds, g, S, E);
        sgemm_phase<1, 1024>(F, B_XN + (size_t)TP * DM, WSP(bf16_t, WS_WO1), 1024); } SEAM(11);
    if (IN(12)) { norm_phase<1>(F, nullptr, nullptr, B_G, P_NG + 5 * 1024); } SEAM(12);
    if (IN(13)) { pg8::Gemm g{WSP(bf16_t, WS_XB), WSP(bf16_t, WS_FIN1), TP, FF2, 1024}; pg8::StaticOrder S; S.init(TP, FF2, F.G, bx);
        pg8::EpiSwiglu E{B_R1, FFH, WSP(float, WS_RS)};
        pg8::gemm_phase<pg8::EpiSwiglu, pg8::StaticOrder, true, true>(F.lds, g, S, E);
        sgemm_phase<2, 1024>(F, WSP(bf16_t, WS_XB) + (size_t)TP * DM, WSP(bf16_t, WS_FIN1), FF2); } SEAM(13);
    if (IN(14)) { pg8::Gemm g{B_R1, WSP(bf16_t, WS_FOUT1), TP, 1024, FFH}; pg8::StaticOrder S; S.init(TP, 1024, F.G, bx);
        pg8::EpiBf16T E{B_G, 1024, 0, 0, 1.0f, 1 << 30};
        pg8::gemm_phase<pg8::EpiBf16T, pg8::StaticOrder, true, true>(F.lds, g, S, E);
        sgemm_phase<1, FFH>(F, B_R1 + (size_t)TP * FFH, WSP(bf16_t, WS_FOUT1), 1024); } SEAM(14);
    if (IN(15)) { norm_phase<2>(F, nullptr, nullptr, B_G, P_NG + 7 * 1024); }
#undef IN
#undef SEAM
#undef B_XN
#undef B_R1
#undef B_G
#undef P_NG
}

extern "C" void kernel_launch(void* const* d_in, const int* in_sizes, int n_in, void* d_out, int out_size, void* d_ws, size_t ws_size, hipStream_t stream) {
    static int grid = 0;
    if (grid == 0) {
        if (n_in != 24 || (size_t)out_size != O_END || ws_size < WS_END) { fprintf(stderr, "kernel_launch: unexpected shapes: n_in %d out %d ws %zu (need 24, %zu, >= %zu); nothing launched\n", n_in, out_size, ws_size, (size_t)O_END, (size_t)WS_END); grid = -1; return; }
        int dev = 0, cus = 0, per_cu = 0;
        if (hipGetDevice(&dev) != hipSuccess || hipDeviceGetAttribute(&cus, hipDeviceAttributeMultiprocessorCount, dev) != hipSuccess) { fprintf(stderr, "kernel_launch: device query failed\n"); grid = -1; return; }
        if (hipFuncSetAttribute((const void*)mk_fwd, hipFuncAttributeMaxDynamicSharedMemorySize, LDS_BYTES) != hipSuccess) { fprintf(stderr, "kernel_launch: hipFuncSetAttribute failed\n"); grid = -1; return; }
        if (hipOccupancyMaxActiveBlocksPerMultiprocessor(&per_cu, (const void*)mk_fwd, NWAVES * 64, LDS_BYTES) != hipSuccess || per_cu < 1) { fprintf(stderr, "kernel_launch: occupancy query reports %d blocks per CU\n", per_cu); }
        (void)hipGetLastError();
        grid = cus;
    }
    if (grid < 0) return;
    if (hipMemsetAsync((char*)d_ws + WS_CTL, 0, CTL_ZERO_BYTES, stream) != hipSuccess) { fprintf(stderr, "kernel_launch: memset failed\n"); return; }
    Args a{};
    for (int i = 0; i < 24; ++i) a.in[i] = (const float*)d_in[i];
    a.out = (float*)d_out; a.ws = (unsigned char*)d_ws;
    for (int l_ = 0; l_ < MK_N_LAUNCHES; ++l_) {
        const int li = (MK_N_LAUNCHES == 1) ? 0 : (l_ <= 10 ? l_ : l_ == 11 ? 16 : (MK_N_LAUNCHES == 18 ? (l_ == 12 ? 17 : l_ - 2) : l_ - 1));
        a.ph_lo = (MK_N_LAUNCHES == 1) ? 0 : li; a.ph_hi = (MK_N_LAUNCHES == 1) ? N_PHASES : li + 1;
        hipLaunchKernelGGL(mk_fwd, dim3(grid), dim3(NWAVES * 64), LDS_BYTES, stream, a);
#ifdef GDIAG
        if (MK_N_LAUNCHES > 1 && li == 6) { Args d = a; d.ph_lo = 18; d.ph_hi = 19; for (int r_ = 0; r_ < 3; ++r_) hipLaunchKernelGGL(mk_fwd, dim3(grid), dim3(NWAVES * 64), LDS_BYTES, stream, d); }
#endif
#ifdef PH_REP
        if (MK_N_LAUNCHES > 1 && ((PH_REP >> li) & 1)) for (int r_ = 0; r_ < 3; ++r_) hipLaunchKernelGGL(mk_fwd, dim3(grid), dim3(NWAVES * 64), LDS_BYTES, stream, a);
#endif
        const hipError_t le = hipPeekAtLastError();
        if (le != hipSuccess) { fprintf(stderr, "kernel_launch: launch %d failed: %s\n", li, hipGetErrorName(le)); break; }
    }
}
```

```cpp
#define MK_N_LAUNCHES 1
#include <hip/hip_runtime.h>
#include <cstdio>
#include <cstdint>
#include <cmath>

#ifndef MK_N_LAUNCHES
#define MK_N_LAUNCHES 1
#endif

constexpr int DM = 1024;
constexpr int TP = 32768, TSM = 256, TT = TP + TSM;
constexpr int PSEQ = 4096, PAST = 2048, SSEQ = 16;
constexpr int MHEADS = 4, MDK = 128, MDV = 256, NPROJ = 3080, NP0 = 3072;
constexpr int AHEADS = 8;
constexpr int FFH = 2816, FF2 = 5632;
constexpr float EPS = 1e-6f;
constexpr float LOG2E = 1.4426950408889634f;
constexpr float QSCALE = 0.125f * LOG2E;
constexpr float LAM_INIT = 0.35550906759096926f;
constexpr int NCH_P = 2048, NCH_ALL = 2112;

constexpr size_t O_YP = 0, O_YS = 33554432, O_PC = 33816576, O_PN = 34865152, O_PM = 34869248, O_PK = 34869280, O_PV = 68423712,
                 O_SC = 101978144, O_SN = 104075296, O_SM = 104083488, O_SK = 104083552, O_SV = 104345696, O_END = 104607840;

constexpr size_t MiB = 1u << 20;
constexpr size_t WS_CTL = 0, CTL_ZERO_BYTES = 1 * MiB;
constexpr size_t WS_GATES = 1 * MiB;
constexpr size_t WS_BCUM = 2 * MiB + 256 * 1024;
constexpr size_t WS_MST = 3 * MiB;
constexpr size_t WS_NST = 3 * MiB + 256 * 1024;
constexpr size_t WS_RS = 4 * MiB + 512 * 1024;
constexpr size_t WS_W = 6 * MiB;
constexpr size_t WS_WIN0 = WS_W, WS_WOUT0 = WS_W + 6 * MiB, WS_FIN0 = WS_W + 8 * MiB, WS_FOUT0 = WS_W + 19 * MiB, WS_KVQ = WS_W + 25 * MiB,
                 WS_WO1 = WS_W + 31 * MiB, WS_FIN1 = WS_W + 33 * MiB, WS_FOUT1 = WS_W + 44 * MiB;
constexpr size_t WS_R1 = 56 * MiB;
constexpr size_t WS_R2 = 250 * MiB;
constexpr size_t WS_XB = WS_R2 + 66 * MiB;
constexpr size_t WS_R3 = 382 * MiB;
constexpr size_t WS_END = 447 * MiB;

#define LAS __attribute__((address_space(3)))
#define GAS __attribute__((address_space(1)))
namespace pg8 {
#define PG8_LAS __attribute__((address_space(3)))
typedef unsigned short bf16_t;
typedef short bf16x8 __attribute__((ext_vector_type(8)));
typedef float f32x4 __attribute__((ext_vector_type(4)));
typedef unsigned u32x4 __attribute__((ext_vector_type(4)));
constexpr int BM = 256, BK = 64, HALF = 128, HTB = HALF * BK * 2  , STAGE_BYTES = 8 * HTB, NXCD = 8, WGM = 8;

__host__ __device__ __forceinline__ int lds_byte(int r, int c) { const int st = (r >> 4) * 2 + (c >> 5), rr = r & 15, cc = c & 31, ob = rr * 64 + cc * 2; return st * 1024 + (ob ^ (((ob >> 9) & 1) << 5)); }
__host__ __device__ __forceinline__ void stage_rc(int b, int& R, int& C) { const int st = b / 1024, sb = b % 1024, swz = sb ^ (((sb >> 9) & 1) << 5); R = (st >> 1) * 16 + swz / 64; C = (st & 1) * 32 + (swz % 64) / 2; }
__host__ __device__ __forceinline__ int perm32(int rho) { const int n = rho >> 4, i = rho & 15; return 8 * (i >> 2) + 4 * n + (i & 3); }

struct Unit { int pm, pn; };
struct Gemm { const bf16_t* A; const bf16_t* Bt; int M, N, K; };

struct StaticOrder {
    int nM, nN, nwg, G, c;
    __host__ __device__ void init(int M, int N, int G_, int c_) { nM = M / BM; nN = N / BM; nwg = nM * nN; G = G_; c = c_; }
    __host__ __device__ bool next(int i, Unit& u) const {
        const long L = (long)i * G + c; if (L >= nwg) return false;
        int wgid = (int)L; { const int q = nwg / NXCD, r = nwg % NXCD, xcd = wgid % NXCD, off = wgid / NXCD; wgid = (xcd < r ? xcd * (q + 1) : r * (q + 1) + (xcd - r) * q) + off; }
        const int nig = WGM * nN, gid = wgid / nig, fm = gid * WGM, gsz = (nM - fm) < WGM ? (nM - fm) : WGM;
        u.pm = fm + ((wgid % nig) % gsz); u.pn = (wgid % nig) / gsz; return true;
    }
    __device__ __forceinline__ void a_ready(const Unit&) const {}
    __device__ __forceinline__ void done(const Unit&) const {}
};
struct SubOrder {
    StaticOrder S; int i0, n;
    __host__ __device__ bool next(int i, Unit& u) const { return i < n && S.next(i0 + i, u); }
    __device__ __forceinline__ void a_ready(const Unit&) const {}
    __device__ __forceinline__ void done(const Unit&) const {}
};
typedef float f32x2 __attribute__((ext_vector_type(2)));
typedef __bf16 bf16x2_t __attribute__((ext_vector_type(2)));
__device__ __forceinline__ unsigned cvt_pk_bf16(float lo, float hi) { f32x2 v = {lo, hi}; bf16x2_t b = __builtin_convertvector(v, bf16x2_t); return __builtin_bit_cast(unsigned, b); }
__device__ __forceinline__ float fast_sigmoid(float x) { return __builtin_amdgcn_rcpf(1.0f + __builtin_amdgcn_exp2f(-1.4426950408889634f * x)); }

struct EpiBf16T {
    static constexpr bool PERM = true, AFTER_DRAIN = false; static constexpr int NST = 16;
    bf16_t* O; int ldc; int m1_lo, m1_hi; float s1; int m2_lo;
    __device__ __forceinline__ void operator()(const f32x4 (&acc)[2][2][4][2], const Unit& u, int wr, int wc, int fr, int fq) const {
        const int row0 = u.pm * BM + wr * 64 + fr, col0 = u.pn * BM + wc * 32 + 8 * fq;
        const bool sg = u.pn >= m2_lo; const float sc = (u.pn >= m1_lo && u.pn < m1_hi) ? s1 : 1.0f;
#pragma unroll
        for (int ai = 0; ai < 2; ++ai)
#pragma unroll
            for (int m = 0; m < 4; ++m) { bf16_t* rowp = O + (size_t)(row0 + ai * HALF + m * 16) * ldc + col0;
#pragma unroll
                for (int bj = 0; bj < 2; ++bj) { f32x4 v0 = acc[ai][bj][m][0] * sc, v1 = acc[ai][bj][m][1] * sc;
                    if (sg) {
#pragma unroll
                        for (int i = 0; i < 4; ++i) { v0[i] = fast_sigmoid(v0[i]); v1[i] = fast_sigmoid(v1[i]); } }
                    u32x4 w; w.x = cvt_pk_bf16(v0[0], v0[1]); w.y = cvt_pk_bf16(v0[2], v0[3]); w.z = cvt_pk_bf16(v1[0], v1[1]); w.w = cvt_pk_bf16(v1[2], v1[3]);
                    *(u32x4*)(rowp + bj * HALF) = w; } }
    }
};
struct EpiSwiglu {
    static constexpr bool PERM = true, AFTER_DRAIN = false; static constexpr int NST = 8;
    bf16_t* O; int ldc; const float* rs;
    __device__ __forceinline__ void operator()(const f32x4 (&acc)[2][2][4][2], const Unit& u, int wr, int wc, int fr, int fq) const {
        const int row0 = u.pm * BM + wr * 64 + fr, col0 = u.pn * HALF + wc * 32 + 8 * fq;
        float rsv[2][4];
#pragma unroll
        for (int ai = 0; ai < 2; ++ai)
#pragma unroll
            for (int m = 0; m < 4; ++m) rsv[ai][m] = rs[row0 + ai * HALF + m * 16];
#pragma unroll
        for (int ai = 0; ai < 2; ++ai)
#pragma unroll
            for (int m = 0; m < 4; ++m) { bf16_t* rowp = O + (size_t)(row0 + ai * HALF + m * 16) * ldc + col0; const float rsc = rsv[ai][m];
                f32x4 r[2];
#pragma unroll
                for (int n = 0; n < 2; ++n) { const f32x4 g = acc[ai][0][m][n] * rsc, up = acc[ai][1][m][n] * rsc;
#pragma unroll
                    for (int i = 0; i < 4; ++i) r[n][i] = g[i] * fast_sigmoid(g[i]) * up[i]; }
                u32x4 w; w.x = cvt_pk_bf16(r[0][0], r[0][1]); w.y = cvt_pk_bf16(r[0][2], r[0][3]); w.z = cvt_pk_bf16(r[1][0], r[1][1]); w.w = cvt_pk_bf16(r[1][2], r[1][3]);
                *(u32x4*)rowp = w; }
    }
};
struct EpiKVQ {
    static constexpr bool PERM = true, AFTER_DRAIN = false; static constexpr int NST = 16;
    bf16_t* O; float* outp; float qscale; const float* rs;
    __device__ __forceinline__ void operator()(const f32x4 (&acc)[2][2][4][2], const Unit& u, int wr, int wc, int fr, int fq) const {
        const int row0 = u.pm * BM + wr * 64 + fr, col0 = u.pn * BM + wc * 32 + 8 * fq;
        const bool isq = u.pn >= 8; const float sc = isq ? qscale : 1.0f;
        float* f = nullptr;
        if (!isq && u.pm >= 128) { const bool isv = u.pn >= 4; const int c = (u.pn & 3) * BM + wc * 32 + 8 * fq;
            f = outp + (u.pm < 128 ? (isv ? O_PV : O_PK) + (size_t)u.pm * BM * 1024 : (isv ? O_SV : O_SK)) + c + (size_t)(wr * 64 + fr) * 1024; }
        float rsv[2][4];
#pragma unroll
        for (int ai = 0; ai < 2; ++ai)
#pragma unroll
            for (int m = 0; m < 4; ++m) rsv[ai][m] = rs[row0 + ai * HALF + m * 16] * sc;
#pragma unroll
        for (int ai = 0; ai < 2; ++ai)
#pragma unroll
            for (int m = 0; m < 4; ++m) { bf16_t* rowp = O + (size_t)(row0 + ai * HALF + m * 16) * 3072 + col0; const float rsc = rsv[ai][m];
#pragma unroll
                for (int bj = 0; bj < 2; ++bj) { const f32x4 v0 = acc[ai][bj][m][0] * rsc, v1 = acc[ai][bj][m][1] * rsc;
                    if (f) { float* fp = f + (size_t)(ai * HALF + m * 16) * 1024 + bj * HALF; *(f32x4*)fp = v0; *(f32x4*)(fp + 4) = v1; }
                    u32x4 w; w.x = cvt_pk_bf16(v0[0], v0[1]); w.y = cvt_pk_bf16(v0[2], v0[3]); w.z = cvt_pk_bf16(v1[0], v1[1]); w.w = cvt_pk_bf16(v1[2], v1[3]);
                    *(u32x4*)(rowp + bj * HALF) = w; } }
    }
};

template <class Epi, class Sched, bool ALIGN_EPI = false, bool SP2 = false, int DG = 0>
__device__ __forceinline__ void gemm_phase(PG8_LAS unsigned char* lds, const Gemm g, const Sched& S, const Epi& E) {
    const int tid = threadIdx.x, wid = __builtin_amdgcn_readfirstlane(tid >> 6), lane = tid & 63, wr = wid >> 2, wc = wid & 3, fr = lane & 15, fq = lane >> 4;
    const int K = g.K, nt = K / BK;
    unsigned voffA[2], voffB[2];
#pragma unroll
    for (int i = 0; i < 2; ++i) { int R, C; stage_rc(tid * 16 + i * 8192, R, C); const int Rb = Epi::PERM ? ((R & ~31) + perm32(R & 31)) : R;
        voffA[i] = (unsigned)(R * K + C) * 2u; voffB[i] = (unsigned)(Rb * K + C) * 2u; }
    const size_t kstep = (size_t)(BK * 2);
    const size_t hstep = (size_t)HALF * K * 2;
    const size_t tstep = 2 * hstep;
    const unsigned ldsw = (unsigned)wid * 1024u;
    const int aoff = lds_byte(wr * 64 + fr, fq * 8), boff = lds_byte(wc * 32 + fr, fq * 8);
#define PG8_SA(b, h) (((b) * 2 + (h)) * HTB)
#define PG8_SB(b, h) ((4 + (b) * 2 + (h)) * HTB)
#define PG8_STAGE(bufoff, gbase, voff) do { if constexpr (DG != 4) { _Pragma("unroll") for (int _i = 0; _i < 2; ++_i) \
        __builtin_amdgcn_global_load_lds((const unsigned*)((const char*)(gbase) + (voff)[_i]), (PG8_LAS unsigned*)(lds + (bufoff) + ldsw + _i * 8192), 16, 0, 0); } } while (0)
#define PG8_LDA(dst, b, h) do { _Pragma("unroll") for (int m = 0; m < 4; ++m) _Pragma("unroll") for (int k = 0; k < 2; ++k) dst[m][k] = *(const PG8_LAS bf16x8*)(lds + PG8_SA(b, h) + aoff + m * 2048 + k * 1024); } while (0)
#define PG8_LDB(dst, b, h) do { _Pragma("unroll") for (int n = 0; n < 2; ++n) _Pragma("unroll") for (int k = 0; k < 2; ++k) dst[n][k] = *(const PG8_LAS bf16x8*)(lds + PG8_SB(b, h) + boff + n * 2048 + k * 1024); } while (0)
#define PG8_MMA(ai, bj, At, Bt) do { __builtin_amdgcn_s_setprio(1); _Pragma("unroll") for (int m = 0; m < 4; ++m) _Pragma("unroll") for (int n = 0; n < 2; ++n) _Pragma("unroll") for (int k = 0; k < 2; ++k) { \
        if constexpr (DG != 3) acc[ai][bj][m][n] = __builtin_amdgcn_mfma_f32_16x16x32_bf16(Bt[n][k], At[m][k], acc[ai][bj][m][n], 0, 0, 0); else asm volatile("" :: "v"(Bt[n][k]), "v"(At[m][k])); } __builtin_amdgcn_s_setprio(0); } while (0)
#define PG8_WAIT_V(n) asm volatile("s_waitcnt vmcnt(" #n ")" ::: "memory")
#define PG8_WAIT_VE(f) asm volatile("s_cmp_lg_u32 %0, 0\n\ts_cbranch_scc1 1f\n\ts_waitcnt vmcnt(8)\n1:\n\ts_waitcnt vmcnt(%1)" :: "s"(f), "n"(8 + Epi::NST) : "memory", "scc")
#define PG8_WAIT_L(n) asm volatile("s_waitcnt lgkmcnt(" #n ")" ::: "memory")
#define PG8_BAR __builtin_amdgcn_s_barrier()
#define PG8_SCHED __builtin_amdgcn_sched_barrier(0)
    Unit cur, nxt; int ui = 0;
    if (!S.next(0, cur)) return;
    f32x4 acc[2][2][4][2];
#pragma unroll
    for (int a = 0; a < 2; ++a)
#pragma unroll
        for (int b = 0; b < 2; ++b)
#pragma unroll
            for (int m = 0; m < 4; ++m)
#pragma unroll
                for (int n = 0; n < 2; ++n) acc[a][b][m][n] = (f32x4){0.f, 0.f, 0.f, 0.f};
    bf16x8 At[4][2], B0[2][2], B1[2][2];
    const char* cA = (const char*)g.A + (size_t)cur.pm * tstep; const char* cB = (const char*)g.Bt + (size_t)cur.pn * tstep;
    S.a_ready(cur);
    if constexpr (SP2) {
        PG8_STAGE(PG8_SB(0, 0), cB, voffB); PG8_STAGE(PG8_SB(0, 1), cB + hstep, voffB); PG8_STAGE(PG8_SA(0, 0), cA, voffA); PG8_STAGE(PG8_SA(0, 1), cA + hstep, voffA);
        if (wr == 1) PG8_BAR;
        PG8_WAIT_V(2); PG8_BAR;
        PG8_STAGE(PG8_SB(1, 0), cB + kstep, voffB); PG8_STAGE(PG8_SA(1, 0), cA + kstep, voffA); PG8_STAGE(PG8_SB(1, 1), cB + hstep + kstep, voffB);
        PG8_WAIT_V(6); PG8_BAR;
    } else {
        PG8_STAGE(PG8_SB(0, 0), cB, voffB); PG8_STAGE(PG8_SA(0, 0), cA, voffA); PG8_STAGE(PG8_SB(0, 1), cB + hstep, voffB); PG8_STAGE(PG8_SA(0, 1), cA + hstep, voffA);
        if (wr == 1) PG8_BAR;
        PG8_WAIT_V(4); PG8_BAR;
        PG8_STAGE(PG8_SB(1, 0), cB + kstep, voffB); PG8_STAGE(PG8_SA(1, 0), cA + kstep, voffA); PG8_STAGE(PG8_SB(1, 1), cB + hstep + kstep, voffB);
        PG8_WAIT_V(6); PG8_BAR;
    }
    for (;;) {
        const bool has_next = S.next(ui + 1, nxt);
        const char* nA = has_next ? (const char*)g.A + (size_t)nxt.pm * tstep : cA; const char* nB = has_next ? (const char*)g.Bt + (size_t)nxt.pn * tstep : cB;
        for (int t = 0; t < nt; t += 2) {
            const bool last = (t == nt - 2);
            const char* a1 = cA + (size_t)(t + 1) * kstep;
            const char* a2 = last ? nA : cA + (size_t)(t + 2) * kstep; const char* b2 = last ? nB : cB + (size_t)(t + 2) * kstep;
            const char* a3 = a2 + kstep; const char* b3 = b2 + kstep;
            if (last && has_next) S.a_ready(nxt);
            const int fta = __builtin_amdgcn_readfirstlane(((t == 0) && (ui > 0)) ? 1 : 0);
            if constexpr (SP2) {
            PG8_LDB(B0, 0, 0); PG8_LDB(B1, 0, 1); PG8_SCHED; PG8_LDA(At, 0, 0); PG8_STAGE(PG8_SA(1, 1), a1 + hstep, voffA);
            PG8_WAIT_VE(fta);
            PG8_WAIT_L(0); PG8_BAR; PG8_MMA(0, 0, At, B0); PG8_MMA(0, 1, At, B1); PG8_BAR; PG8_SCHED;
            PG8_LDA(At, 0, 1); PG8_STAGE(PG8_SB(0, 0), b2, voffB); PG8_STAGE(PG8_SB(0, 1), b2 + hstep, voffB); PG8_STAGE(PG8_SA(0, 0), a2, voffA);
            PG8_WAIT_VE(fta);
            PG8_WAIT_L(0); PG8_BAR; PG8_MMA(1, 0, At, B0); PG8_MMA(1, 1, At, B1); PG8_BAR; PG8_SCHED;
            PG8_LDB(B0, 1, 0); PG8_LDB(B1, 1, 1); PG8_SCHED; PG8_LDA(At, 1, 0); PG8_STAGE(PG8_SA(0, 1), a2 + hstep, voffA);
            PG8_WAIT_V(8); PG8_WAIT_L(0); PG8_BAR; PG8_MMA(0, 0, At, B0); PG8_MMA(0, 1, At, B1); PG8_BAR; PG8_SCHED;
            PG8_LDA(At, 1, 1); PG8_STAGE(PG8_SB(1, 0), b3, voffB); PG8_STAGE(PG8_SB(1, 1), b3 + hstep, voffB); PG8_STAGE(PG8_SA(1, 0), a3, voffA);
            PG8_WAIT_V(8); PG8_WAIT_L(0); PG8_BAR; PG8_MMA(1, 0, At, B0); PG8_MMA(1, 1, At, B1); PG8_BAR; PG8_SCHED;
            } else {
            PG8_LDB(B0, 0, 0); PG8_SCHED; PG8_LDA(At, 0, 0); PG8_STAGE(PG8_SA(1, 1), a1 + hstep, voffA);
            PG8_WAIT_L(8); PG8_BAR; PG8_WAIT_L(0); PG8_MMA(0, 0, At, B0); PG8_BAR; PG8_SCHED;
            PG8_LDB(B1, 0, 1); PG8_STAGE(PG8_SB(0, 0), b2, voffB);
            PG8_BAR; PG8_WAIT_L(0); PG8_MMA(0, 1, At, B1); PG8_BAR;
            PG8_LDA(At, 0, 1); PG8_STAGE(PG8_SA(0, 0), a2, voffA);
            PG8_BAR; PG8_WAIT_L(0); PG8_MMA(1, 0, At, B0); PG8_BAR; PG8_SCHED;
            PG8_STAGE(PG8_SB(0, 1), b2 + hstep, voffB);
            PG8_WAIT_V(6); PG8_BAR; PG8_MMA(1, 1, At, B1); PG8_BAR;
            PG8_LDB(B0, 1, 0); PG8_SCHED; PG8_LDA(At, 1, 0); PG8_STAGE(PG8_SA(0, 1), a2 + hstep, voffA);
            PG8_WAIT_L(8); PG8_BAR; PG8_WAIT_L(0); PG8_MMA(0, 0, At, B0); PG8_BAR; PG8_SCHED;
            PG8_LDB(B1, 1, 1); PG8_STAGE(PG8_SB(1, 0), b3, voffB);
            PG8_BAR; PG8_WAIT_L(0); PG8_MMA(0, 1, At, B1); PG8_BAR;
            PG8_LDA(At, 1, 1); PG8_STAGE(PG8_SA(1, 0), a3, voffA);
            PG8_BAR; PG8_WAIT_L(0); PG8_MMA(1, 0, At, B0); PG8_BAR; PG8_SCHED;
            PG8_STAGE(PG8_SB(1, 1), b3 + hstep, voffB);
            PG8_WAIT_V(6); PG8_BAR; PG8_MMA(1, 1, At, B1); PG8_BAR;
            }
        }
        if constexpr (ALIGN_EPI) { if (wr == 0) PG8_BAR; }
        if constexpr (DG >= 2) {
#pragma unroll
            for (int a = 0; a < 2; ++a)
#pragma unroll
                for (int b = 0; b < 2; ++b)
#pragma unroll
                    for (int m = 0; m < 4; ++m)
#pragma unroll
                        for (int n = 0; n < 2; ++n) asm volatile("" :: "v"(acc[a][b][m][n]));
        } else
        if constexpr (!Epi::AFTER_DRAIN) { E(acc, cur, wr, wc, fr, fq); S.done(cur); }
        if (!has_next) break;
#pragma unroll
        for (int a = 0; a < 2; ++a)
#pragma unroll
            for (int b = 0; b < 2; ++b)
#pragma unroll
                for (int m = 0; m < 4; ++m)
#pragma unroll
                    for (int n = 0; n < 2; ++n) acc[a][b][m][n] = (f32x4){0.f, 0.f, 0.f, 0.f};
        cur = nxt; cA = nA; cB = nB; ++ui;
        if constexpr (ALIGN_EPI) { if (wr == 1) PG8_BAR; }
    }
    PG8_WAIT_V(0);
    if constexpr (!ALIGN_EPI) { if (wr == 0) PG8_BAR; }
    PG8_BAR;
    if constexpr (Epi::AFTER_DRAIN) { E.fused(acc, cur, wr, wc, fr, fq, lds, wid, lane); S.done(cur); }
#undef PG8_SA
#undef PG8_SB
#undef PG8_STAGE
#undef PG8_LDA
#undef PG8_LDB
#undef PG8_MMA
#undef PG8_WAIT_V
#undef PG8_WAIT_VE
#undef PG8_WAIT_L
#undef PG8_BAR
#undef PG8_SCHED
}
}
constexpr int NWAVES = 8;
constexpr int RING_BYTES = 157696;
constexpr int LDSCTL_OFF = RING_BYTES, MISC_OFF = LDSCTL_OFF + 320;
constexpr int LDS_BYTES = 159744;
constexpr int CW_ATQ = 16384;
constexpr int CW_GRP = 49152;
constexpr int CW_BAR = 4096;

typedef unsigned short bf16_t;
typedef short bf16x8 __attribute__((ext_vector_type(8)));
typedef short s16x4 __attribute__((ext_vector_type(4)));
typedef float f32x2 __attribute__((ext_vector_type(2)));
typedef float f32x4 __attribute__((ext_vector_type(4)));
typedef float f32x16 __attribute__((ext_vector_type(16)));
typedef unsigned u32x2 __attribute__((ext_vector_type(2)));
typedef unsigned u32x4 __attribute__((ext_vector_type(4)));
typedef GAS unsigned gu32;
#define RLX_AGENT __ATOMIC_RELAXED, __HIP_MEMORY_SCOPE_AGENT
#define LDS_WAIT() asm volatile("s_waitcnt lgkmcnt(0)" ::: "memory")
#define VM_WAIT() asm volatile("s_waitcnt vmcnt(0)" ::: "memory")
using pg8::cvt_pk_bf16;
__device__ __forceinline__ float bflo(unsigned w) { return __uint_as_float(w << 16); }
__device__ __forceinline__ float bfhi(unsigned w) { return __uint_as_float(w & 0xffff0000u); }
__device__ __forceinline__ int crow(int r, int hi) { return (r & 3) + 8 * (r >> 2) + 4 * hi; }
__device__ __forceinline__ float wave_sum(float v) {
#pragma unroll
    for (int o = 1; o < 64; o <<= 1) v += __shfl_xor(v, o);
    return v;
}
__device__ __forceinline__ float wave_max(float v) {
#pragma unroll
    for (int o = 1; o < 64; o <<= 1) v = fmaxf(v, __shfl_xor(v, o));
    return v;
}
__device__ __forceinline__ float max3f(float a, float b, float c) { float r; asm("v_max3_f32 %0, %1, %2, %3" : "=v"(r) : "v"(a), "v"(b), "v"(c)); return r; }
__device__ __forceinline__ float swap_add(float v) { auto r = __builtin_amdgcn_permlane32_swap(__float_as_uint(v), __float_as_uint(v), false, false); return __uint_as_float(r[0]) + __uint_as_float(r[1]); }
__device__ __forceinline__ float swap_max(float v) { auto r = __builtin_amdgcn_permlane32_swap(__float_as_uint(v), __float_as_uint(v), false, false); return fmaxf(__uint_as_float(r[0]), __uint_as_float(r[1])); }
typedef short v4i16_t __attribute__((ext_vector_type(4)));
__device__ __forceinline__ s16x4 vtr(LAS const unsigned char* p) { return __builtin_bit_cast(s16x4, __builtin_amdgcn_ds_read_tr16_b64_v4i16((LAS v4i16_t*)p)); }
#define MFMA32(a, b, c) __builtin_amdgcn_mfma_f32_32x32x16_bf16((a), (b), (c), 0, 0, 0)
#define MFMA16(a, b, c) __builtin_amdgcn_mfma_f32_16x16x32_bf16((a), (b), (c), 0, 0, 0)
__device__ __forceinline__ bf16x8 pack8(const f32x16& x, int s) {
    u32x4 p; p.x = cvt_pk_bf16(x[8 * s + 0], x[8 * s + 1]); p.y = cvt_pk_bf16(x[8 * s + 2], x[8 * s + 3]); p.z = cvt_pk_bf16(x[8 * s + 4], x[8 * s + 5]); p.w = cvt_pk_bf16(x[8 * s + 6], x[8 * s + 7]);
    return __builtin_bit_cast(bf16x8, p);
}
__device__ __forceinline__ bf16x8 mk_vfrag(s16x4 lo, s16x4 hi) { return (bf16x8){lo[0], lo[1], lo[2], lo[3], hi[0], hi[1], hi[2], hi[3]}; }

__device__ __forceinline__ void glds16(const void* gsrc, unsigned lds_dst) { unsigned keep;
    asm volatile("s_mov_b32 %0, m0\n\ts_mov_b32 m0, %2\n\ts_nop 0\n\tglobal_load_lds_dwordx4 %1, off\n\ts_mov_b32 m0, %0" : "=&s"(keep) : "v"(gsrc), "s"(lds_dst) : "memory"); }
template <class T> __device__ __forceinline__ T* vptr(T* p) { unsigned long long x = (unsigned long long)p; unsigned lo = (unsigned)x, hi = (unsigned)(x >> 32); asm volatile("" : "+v"(lo), "+v"(hi)); return (T*)(GAS T*)(((unsigned long long)hi << 32) | lo); }
__device__ __forceinline__ void glds16s(const void* sbase, unsigned voff, unsigned lds_dst) { unsigned keep;
    asm volatile("s_nop 4\n\ts_mov_b32 %0, m0\n\ts_mov_b32 m0, %3\n\ts_nop 0\n\tglobal_load_lds_dwordx4 %1, %2\n\ts_mov_b32 m0, %0" : "=&s"(keep) : "v"(voff), "s"(sbase), "s"(lds_dst) : "memory"); }
#define XB_TMO      128
#define XB_XCNT(j)  (256  + 64 * (j))
#define XB_XSUB(j)  (1280 + 64 * (j))
#define XB_XGEN(j)  (2304 + 64 * (j))
#define XB_TOP      3328
#define XB_TOPGEN   3392
#define XCD_BAR_WORDS 3456
#define XB_SPIN_CAP (1u << 18)

__device__ __forceinline__ unsigned xb_ld(unsigned* p)              { return __hip_atomic_load(p, __ATOMIC_RELAXED, __HIP_MEMORY_SCOPE_AGENT); }
__device__ __forceinline__ unsigned xb_add(unsigned* p, unsigned v) { return __hip_atomic_fetch_add(p, v, __ATOMIC_RELAXED, __HIP_MEMORY_SCOPE_AGENT); }
__device__ __forceinline__ unsigned xb_xcc_id() { return (unsigned)__builtin_amdgcn_s_getreg((3 << 11) | 20) & 0xFu; }
#define XB_SPIN(cond, bar) do { unsigned _sp = 0; while (cond) { __builtin_amdgcn_s_sleep(1); \
    if ((++_sp & 255u) == 0u) { if (xb_ld(&(bar)[XB_TMO])) break; if (_sp > XB_SPIN_CAP) { atomicAdd(&(bar)[XB_TMO], 1u); break; } } } } while (0)

struct XcdBarrier {
    unsigned* bar; unsigned x;
    volatile LAS unsigned* st;
};

__device__ __forceinline__ XcdBarrier xcd_barrier_post(unsigned* bar, volatile LAS unsigned* st) {
    XcdBarrier b; b.bar = bar; b.x = xb_xcc_id(); b.st = st;
    if (threadIdx.x == 0) (void)xb_add(&bar[XB_XCNT(b.x)], 1u);
    return b;
}
__device__ __forceinline__ void xcd_barrier_complete(unsigned* bar, unsigned x, unsigned& nloc, unsigned& nx) {
    const unsigned G = gridDim.x * gridDim.y * gridDim.z;
    unsigned sum, cnt, mine, sp = 0u;
    for (;;) {
        sum = 0u; cnt = 0u; mine = 0u;
#pragma unroll
        for (unsigned j = 0; j < 16; ++j) { const unsigned c = xb_ld(&bar[XB_XCNT(j)]); sum += c; cnt += (c > 0u) ? 1u : 0u; mine = (j == x) ? c : mine; }
        if (sum == G) break;
        __builtin_amdgcn_s_sleep(1);
        if ((++sp & 255u) == 0u) { if (xb_ld(&bar[XB_TMO])) break; if (sp > XB_SPIN_CAP) { atomicAdd(&bar[XB_TMO], 1u); break; } }
    }
    nloc = mine > 0u ? mine : 1u; nx = cnt > 0u ? cnt : 1u;
}

__device__ __forceinline__ void xcd_barrier(const XcdBarrier& b) {
    asm volatile("s_waitcnt vmcnt(0)" ::: "memory");
    __syncthreads();
    if (threadIdx.x == 0) {
        unsigned* bar = b.bar;
        __builtin_amdgcn_s_waitcnt(0);
        unsigned nloc = b.st[0], nx = b.st[1];
        if (nloc == 0u) { xcd_barrier_complete(bar, b.x, nloc, nx); b.st[0] = nloc; b.st[1] = nx; }
        const unsigned old = xb_add(&bar[XB_XSUB(b.x)], 1u);
        const unsigned gen = old / nloc;
        if (old + 1u == (gen + 1u) * nloc) {
            __builtin_amdgcn_fence(__ATOMIC_RELEASE, "agent");
            asm volatile("s_waitcnt vmcnt(0)" ::: "memory");
            const unsigned og = xb_add(&bar[XB_TOP], 1u);
            const unsigned tg = og / nx;
            if (og + 1u == (tg + 1u) * nx) xb_add(&bar[XB_TOPGEN], 1u);
            else XB_SPIN(xb_ld(&bar[XB_TOPGEN]) == tg, bar);
            __builtin_amdgcn_fence(__ATOMIC_ACQUIRE, "agent");
            xb_add(&bar[XB_XGEN(b.x)], 1u);
            asm volatile("s_waitcnt vmcnt(0)" ::: "memory");
        } else {
            XB_SPIN(xb_ld(&bar[XB_XGEN(b.x)]) == gen, bar);
            __builtin_amdgcn_fence(__ATOMIC_ACQUIRE, "agent");
            asm volatile("s_waitcnt vmcnt(0)" ::: "memory");
        }
    }
    __syncthreads();
}
typedef const float* cfptr_t;
typedef const cfptr_t __attribute__((address_space(4)))* kargp_t;
struct Frame {
    LAS unsigned char* lds;
    volatile LAS unsigned* MISC;
    gu32* ctl;
    int tid, lane, wave;
    int vcu, G;
    kargp_t in; float* out; unsigned char* ws;
};
#define WSP(T, off) ((T*)(F.ws + (off)))

__device__ __forceinline__ void wconv_load(const float* W, int ldw, int srccol0, const float* gain, int k0, int lane, float (&wv)[32], f32x4& g0, f32x4& g1) {
    const float* wp = W + (size_t)(k0 + (lane >> 5)) * ldw + srccol0 + (lane & 31);
#pragma unroll
    for (int i = 0; i < 32; ++i) wv[i] = wp[(size_t)(2 * i) * ldw];
    g0 = (f32x4){1.f, 1.f, 1.f, 1.f}; g1 = g0;
    if (gain) { g0 = *(const f32x4*)(gain + k0 + 8 * (lane & 7)); g1 = *(const f32x4*)(gain + k0 + 8 * (lane & 7) + 4); }
}
__device__ __forceinline__ void wconv_store(const float (&wv)[32], const f32x4 g0, const f32x4 g1, bf16_t* WT, int K, int dstrow0, int k0, LAS float* scr, int lane) {
    const int c = lane & 7;
#pragma unroll
    for (int i = 0; i < 32; ++i) scr[(2 * i + (lane >> 5)) * 33 + (lane & 31)] = wv[i];
    LDS_WAIT(); asm volatile("" ::: "memory");
#pragma unroll
    for (int j = 0; j < 4; ++j) { const int n = (lane >> 3) + 8 * j; const LAS float* s = scr + (8 * c) * 33 + n;
        u32x4 o; o.x = cvt_pk_bf16(s[0 * 33] * g0.x, s[1 * 33] * g0.y); o.y = cvt_pk_bf16(s[2 * 33] * g0.z, s[3 * 33] * g0.w); o.z = cvt_pk_bf16(s[4 * 33] * g1.x, s[5 * 33] * g1.y); o.w = cvt_pk_bf16(s[6 * 33] * g1.z, s[7 * 33] * g1.w);
        *(GAS u32x4*)(WT + (size_t)(dstrow0 + n) * K + k0 + 8 * c) = o; }
    LDS_WAIT(); asm volatile("" ::: "memory");
}
__device__ __forceinline__ void wconv_item(const float* W, int ldw, int srccol0, const float* gain, bf16_t* WT, int K, int dstrow0, int k0, LAS float* scr, int lane) {
    float wv[32]; f32x4 g0, g1; wconv_load(W, ldw, srccol0, gain, k0, lane, wv, g0, g1); wconv_store(wv, g0, g1, WT, K, dstrow0, k0, scr, lane);
}
__device__ __forceinline__ int ffn_srccol(int j0) { const int pn = j0 >> 8, jj = j0 & 255; return jj < 128 ? 128 * pn + jj : FFH + 128 * pn + (jj - 128); }
__device__ __forceinline__ float log_sigmoid(float x) { return fminf(x, 0.0f) - log1pf(expf(-fabsf(x))); }

constexpr int WC_I0 = 16 * 96, WC_I1 = 16 * 32, WC_I2 = 16 * 176, WC_I3 = 44 * 32, WC_I4 = 16 * 64, WC_I5 = 16 * 32, WC_I6 = 16 * 32, WC_I7 = WC_I2, WC_I8 = WC_I3;
constexpr int WC_LATE = WC_I1 + WC_I2 + WC_I3 + WC_I4 + WC_I5 + WC_I6 + WC_I7 + WC_I8, WC_TAIL = WC_I7 + WC_I8;
struct WcItem { const float* W; int ldw, srccol0; const float* gain; bf16_t* WT; int K, dstrow0, k0; };
__device__ __forceinline__ WcItem wc_late_item(Frame& F, int r) {
    const float* ng = F.in[7]; WcItem t;
    if (r < WC_I1) { const int kb = r / 32, nb = r % 32; t = WcItem{F.in[11], 1024, nb * 32, nullptr, WSP(bf16_t, WS_WOUT0), 1024, nb * 32, kb * 64}; return t; } r -= WC_I1;
    if (r < WC_I2) { const int kb = r / 176, nb = r % 176; t = WcItem{F.in[22], FF2, ffn_srccol(nb * 32), ng + 2 * 1024, WSP(bf16_t, WS_FIN0), 1024, nb * 32, kb * 64}; return t; } r -= WC_I2;
    if (r < WC_I3) { const int kb = r / 32, nb = r % 32; t = WcItem{F.in[23], 1024, nb * 32, nullptr, WSP(bf16_t, WS_FOUT0), FFH, nb * 32, kb * 64}; return t; } r -= WC_I3;
    if (r < WC_I4) { const int kb = r / 64, nb = r % 64; t = WcItem{F.in[13], 2048, nb * 32, F.in[12], WSP(bf16_t, WS_KVQ), 1024, nb * 32, kb * 64}; return t; } r -= WC_I4;
    if (r < WC_I5) { const int kb = r / 32, nb = r % 32; t = WcItem{F.in[15], 1024, nb * 32, ng + 4 * 1024, WSP(bf16_t, WS_KVQ), 1024, 2048 + nb * 32, kb * 64}; return t; } r -= WC_I5;
    if (r < WC_I6) { const int kb = r / 32, nb = r % 32; t = WcItem{F.in[21], 1024, nb * 32, nullptr, WSP(bf16_t, WS_WO1), 1024, nb * 32, kb * 64}; return t; } r -= WC_I6;
    if (r < WC_I7) { const int kb = r / 176, nb = r % 176; t = WcItem{F.in[22] + (size_t)1024 * FF2, FF2, ffn_srccol(nb * 32), ng + 6 * 1024, WSP(bf16_t, WS_FIN1), 1024, nb * 32, kb * 64}; return t; } r -= WC_I7;
    { const int kb = r / 32, nb = r % 32; t = WcItem{F.in[23] + (size_t)FFH * 1024, 1024, nb * 32, nullptr, WSP(bf16_t, WS_FOUT1), FFH, nb * 32, kb * 64}; return t; }
}
__device__ __forceinline__ void p0_prologue(Frame& F) {
    LAS float* scr = (LAS float*)(F.lds + F.wave * 16384);
    const int gw = F.vcu * NWAVES + F.wave, NGW = F.G * NWAVES;
    const float* ng = F.in[7];
    for (int it = gw; it < WC_I0 + (WC_LATE - WC_TAIL); it += NGW) {
        if (it < WC_I0) { const int kb = it / 96, nb = it % 96; wconv_item(F.in[8], NPROJ, nb * 32, ng, WSP(bf16_t, WS_WIN0), 1024, nb * 32, kb * 64, scr, F.lane); }
        else { const WcItem t = wc_late_item(F, it - WC_I0); wconv_item(t.W, t.ldw, t.srccol0, t.gain, t.WT, t.K, t.dstrow0, t.k0, scr, F.lane); }
    }
    __syncthreads();
    LAS float* wg = (LAS float*)F.lds;
    for (int k = F.tid; k < 1024; k += NWAVES * 64) { const float g = ng[k]; const f32x4 a = *(const f32x4*)(F.in[8] + (size_t)k * NPROJ + NP0), b = *(const f32x4*)(F.in[8] + (size_t)k * NPROJ + NP0 + 4);
        wg[0 * 1024 + k] = a[0] * g; wg[1 * 1024 + k] = a[1] * g; wg[2 * 1024 + k] = a[2] * g; wg[3 * 1024 + k] = a[3] * g;
        wg[4 * 1024 + k] = b[0] * g; wg[5 * 1024 + k] = b[1] * g; wg[6 * 1024 + k] = b[2] * g; wg[7 * 1024 + k] = b[3] * g; }
    __syncthreads();
    const int gsel = ((F.lane & 1) << 2) | (F.lane & 2) | ((F.lane >> 2) & 1);
    const float bg = F.in[9][gsel];
    bf16_t* XN = WSP(bf16_t, WS_R3); float* GT = WSP(float, WS_GATES);
    f32x4 vn[4];
#define P0_LOAD(mm) do { const float* xrow_ = (mm) < TP ? F.in[0] + (size_t)(mm) * DM : F.in[1] + (size_t)((mm) - TP) * DM; const GAS f32x4* xr_ = (const GAS f32x4*)xrow_ + F.lane; \
        _Pragma("unroll") for (int j = 0; j < 4; ++j) vn[j] = xr_[64 * j]; } while (0)
    if (gw < TT) P0_LOAD(gw);
    for (int m = gw; m < TT; m += NGW) {
        f32x4 v[4]; float s = 0.f;
#pragma unroll
        for (int j = 0; j < 4; ++j) { v[j] = vn[j]; s += (v[j].x * v[j].x + v[j].y * v[j].y) + (v[j].z * v[j].z + v[j].w * v[j].w); }
        if (m + NGW < TT) P0_LOAD(m + NGW);
        const float rstd = 1.0f / sqrtf(wave_sum(s) * (1.0f / DM) + EPS);
        GAS unsigned long long* o8 = (GAS unsigned long long*)(XN + (size_t)m * DM) + F.lane;
#pragma unroll
        for (int j = 0; j < 4; ++j) o8[64 * j] = (unsigned long long)cvt_pk_bf16(v[j].x * rstd, v[j].y * rstd) | ((unsigned long long)cvt_pk_bf16(v[j].z * rstd, v[j].w * rstd) << 32);
        float p[8];
#pragma unroll
        for (int g = 0; g < 8; ++g) { float a = 0.f;
#pragma unroll
            for (int j = 0; j < 4; ++j) { const f32x4 w = *(const LAS f32x4*)(wg + g * 1024 + 256 * j + 4 * F.lane); a += (v[j].x * w.x + v[j].y * w.y) + (v[j].z * w.z + v[j].w * w.w); }
            p[g] = a; }
        const bool b0 = F.lane & 1, b1 = F.lane & 2, b2 = F.lane & 4;
        float k4[4], k2[2], val;
#pragma unroll
        for (int i = 0; i < 4; ++i) { const float snd = b0 ? p[i] : p[i + 4]; const float rcv = __shfl_xor(snd, 1); k4[i] = (b0 ? p[i + 4] : p[i]) + rcv; }
#pragma unroll
        for (int i = 0; i < 2; ++i) { const float snd = b1 ? k4[i] : k4[i + 2]; const float rcv = __shfl_xor(snd, 2); k2[i] = (b1 ? k4[i + 2] : k4[i]) + rcv; }
        { const float snd = b2 ? k2[0] : k2[1]; const float rcv = __shfl_xor(snd, 4); val = (b2 ? k2[1] : k2[0]) + rcv; }
        val += __shfl_xor(val, 8); val += __shfl_xor(val, 16); val += __shfl_xor(val, 32);
        val = val * rstd + bg;
        if (gsel >= 4) val = log_sigmoid(val);
        if (F.lane < 8) GT[(size_t)m * 8 + gsel] = val;
    }
#undef P0_LOAD
}

template <int MODE>
__device__ __forceinline__ void norm_phase(Frame& F, const float* xin_p, const float* xin_s, const bf16_t* Gb, const float* g1) {
    const int gw = F.vcu * NWAVES + F.wave, NGW = F.G * NWAVES;
    bf16_t* XB = WSP(bf16_t, WS_XB); float* RS = WSP(float, WS_RS);
    f32x4 gv[4];
#pragma unroll
    for (int j = 0; j < 4; ++j) gv[j] = *((const f32x4*)g1 + F.lane + 64 * j);
    auto load_row = [&](int m, f32x4 (&x)[4], f32x4 (&h)[4]) {
        const GAS u32x2* gr = (const GAS u32x2*)(Gb + (size_t)m * DM) + F.lane;
        if (MODE == 0) { const float* xrow = m < TP ? xin_p + (size_t)m * DM : xin_s + (size_t)(m - TP) * DM; const GAS f32x4* xr = (const GAS f32x4*)xrow + F.lane;
#pragma unroll
            for (int j = 0; j < 4; ++j) x[j] = xr[64 * j]; }
        else { const GAS u32x2* xr = (const GAS u32x2*)(XB + (size_t)m * DM) + F.lane;
#pragma unroll
            for (int j = 0; j < 4; ++j) { const u32x2 w = xr[64 * j]; x[j] = (f32x4){bflo(w.x), bfhi(w.x), bflo(w.y), bfhi(w.y)}; } }
#pragma unroll
        for (int j = 0; j < 4; ++j) { const u32x2 w = gr[64 * j]; h[j] = (f32x4){bflo(w.x), bfhi(w.x), bflo(w.y), bfhi(w.y)}; }
    };
    auto do_row = [&](int m, f32x4 (&x)[4], f32x4 (&h)[4]) {
        float s = 0.f;
#pragma unroll
        for (int j = 0; j < 4; ++j) s += (h[j].x * h[j].x + h[j].y * h[j].y) + (h[j].z * h[j].z + h[j].w * h[j].w);
        const float r1 = 1.0f / sqrtf(wave_sum(s) * (1.0f / DM) + EPS);
#pragma unroll
        for (int j = 0; j < 4; ++j) x[j] = x[j] + h[j] * r1 * gv[j];
        if (MODE == 2) { GAS f32x4* xo = (GAS f32x4*)(F.out + (size_t)m * DM) + F.lane;
#pragma unroll
            for (int j = 0; j < 4; ++j) xo[64 * j] = x[j]; }
        else {
            unsigned long long pk[4]; float s2 = 0.f;
#pragma unroll
            for (int j = 0; j < 4; ++j) { const unsigned lo = cvt_pk_bf16(x[j].x, x[j].y), hi = cvt_pk_bf16(x[j].z, x[j].w); pk[j] = (unsigned long long)lo | ((unsigned long long)hi << 32);
                const float a = bflo(lo), b = bfhi(lo), c = bflo(hi), d = bfhi(hi); s2 += (a * a + b * b) + (c * c + d * d); }
            GAS unsigned long long* o8 = (GAS unsigned long long*)(XB + (size_t)m * DM) + F.lane;
#pragma unroll
            for (int j = 0; j < 4; ++j) o8[64 * j] = pk[j];
            const float r2 = 1.0f / sqrtf(wave_sum(s2) * (1.0f / DM) + EPS);
            if (F.lane == 0) RS[m] = r2;
        }
    };
    for (int m = gw; m < TT; m += 2 * NGW) {
        const int m1 = m + NGW; const bool two = m1 < TT;
        f32x4 xa[4], ha[4], xb[4], hb[4];
        load_row(m, xa, ha); load_row(two ? m1 : m, xb, hb);
        do_row(m, xa, ha);
        if (two) do_row(m1, xb, hb);
    }
}
template <int EPI, int K>
__device__ __forceinline__ void sgemm_phase(Frame& F, const bf16_t* A, const bf16_t* Wt, int N) {
    constexpr int KW = K / 8, STEPS = KW / 16, UN = (STEPS % 11 == 0) ? 11 : 8;
    const int tid = F.tid, lane = F.lane, w = F.wave, r32 = lane & 31, hi = lane >> 5;
    const int nct = (EPI == 2 ? FFH : N) / 32, nu = 8 * nct;
    LAS float* PART = (LAS float*)F.lds;
    for (int u = F.vcu; u < nu; u += F.G) {
        const int rt = u & 7, ct = u >> 3;
        int wr0 = 32 * ct, wr1 = 0;
        if (EPI == 2) { const int p = (32 * ct) >> 7, i = (32 * ct) & 127; wr0 = 256 * p + i; wr1 = wr0 + 128; }
        const bf16_t* ap = A + (size_t)(32 * rt + r32) * K + w * KW + 8 * hi;
        const bf16_t* b0p = Wt + (size_t)(wr0 + r32) * K + w * KW + 8 * hi; const bf16_t* b1p = Wt + (size_t)(wr1 + r32) * K + w * KW + 8 * hi;
        f32x16 acc0 = {}, acc1 = {};
#pragma unroll
        for (int s0 = 0; s0 < STEPS; s0 += UN) {
            bf16x8 av[UN], bv[UN], cv[UN];
#pragma unroll
            for (int s = 0; s < UN; ++s) { av[s] = *(const bf16x8*)(ap + 16 * (s0 + s)); bv[s] = *(const bf16x8*)(b0p + 16 * (s0 + s)); if (EPI == 2) cv[s] = *(const bf16x8*)(b1p + 16 * (s0 + s)); }
#pragma unroll
            for (int s = 0; s < UN; ++s) { acc0 = MFMA32(av[s], bv[s], acc0); if (EPI == 2) acc1 = MFMA32(av[s], cv[s], acc1); }
        }
#pragma unroll
        for (int r = 0; r < 16; ++r) { PART[(w * 32 + crow(r, hi)) * 32 + r32] = acc0[r]; if (EPI == 2) PART[8192 + (w * 32 + crow(r, hi)) * 32 + r32] = acc1[r]; }
        asm volatile("s_waitcnt lgkmcnt(0)\n\ts_barrier" ::: "memory");
        { const int row = tid >> 4, c2 = (tid & 15) * 2; f32x2 v = {0.f, 0.f}, up = {0.f, 0.f};
#pragma unroll
          for (int ww = 0; ww < 8; ++ww) { v += *(const LAS f32x2*)(PART + (ww * 32 + row) * 32 + c2); if (EPI == 2) up += *(const LAS f32x2*)(PART + 8192 + (ww * 32 + row) * 32 + c2); }
          const size_t grow = (size_t)TP + 32 * rt + row; const int c = 32 * ct + c2;
          if (EPI >= 2) { const float rsc = WSP(float, WS_RS)[grow]; v *= rsc; up *= rsc; }
          if (EPI == 0) { const int pn = c >> 8; if (pn >= 2 && pn < 4) v *= 0.08838834764831845f; if (pn >= 8) { v.x = pg8::fast_sigmoid(v.x); v.y = pg8::fast_sigmoid(v.y); }
              *(unsigned*)(WSP(bf16_t, WS_R1) + grow * NP0 + c) = cvt_pk_bf16(v.x, v.y); }
          if (EPI == 1) *(unsigned*)(WSP(bf16_t, WS_R2) + grow * DM + c) = cvt_pk_bf16(v.x, v.y);
          if (EPI == 2) *(unsigned*)(WSP(bf16_t, WS_R1) + grow * FFH + c) = cvt_pk_bf16(v.x * pg8::fast_sigmoid(v.x) * up.x, v.y * pg8::fast_sigmoid(v.y) * up.y);
          if (EPI == 3) { const size_t srow = (size_t)(32 * rt + row);
              if (c < 1024) *(f32x2*)(F.out + O_SK + srow * 1024 + c) = v; else if (c < 2048) *(f32x2*)(F.out + O_SV + srow * 1024 + (c - 1024)) = v; else v *= QSCALE;
              *(unsigned*)(WSP(bf16_t, WS_R1) + grow * 3072 + c) = cvt_pk_bf16(v.x, v.y); } }
        asm volatile("s_waitcnt lgkmcnt(0)\n\ts_barrier" ::: "memory");
    }
}

#define LBAR() asm volatile("s_waitcnt lgkmcnt(0)\n\ts_barrier" ::: "memory")
constexpr int M2_ALOG = 0, M2_AC = 16384, M2_BC = 16640, M2_MC = 16896, M2_WST = 17408, M2_WROW = 17664, M2_KT = 18432, M2_VT = 36864, M2_PITCH = 72;
__device__ __forceinline__ void m2_unit(Frame& F, int u) {
    const bool samp = u >= 256; const int uu = samp ? u - 256 : u; const int bh = uu >> 3, sl = uu & 7, b = bh >> 2, h = bh & 3;
    const int nchunk = samp ? 1 : 64, ntok = samp ? 16 : 64;
    const size_t row_base = samp ? (size_t)TP + b * 16 : (size_t)b * PSEQ;
    const int ch0 = samp ? NCH_P + bh : bh * 64;
    const float m0 = samp ? F.in[4][bh] : 0.0f;
    const int tid = F.tid, lane = F.lane, w = F.wave, fr = lane & 15, fq = lane >> 4;
    LAS float* ALOG = (LAS float*)(F.lds + M2_ALOG); LAS float* AC = (LAS float*)(F.lds + M2_AC); LAS float* BC = (LAS float*)(F.lds + M2_BC);
    LAS float* MC = (LAS float*)(F.lds + M2_MC); LAS float* WST = (LAS float*)(F.lds + M2_WST); LAS float* WROW = (LAS float*)(F.lds + M2_WROW);
    LAS bf16_t* KT = (LAS bf16_t*)(F.lds + M2_KT); LAS bf16_t* VT = (LAS bf16_t*)(F.lds + M2_VT);
    const float* GT = WSP(float, WS_GATES); float* BCUM = WSP(float, WS_BCUM); float* MST = WSP(float, WS_MST); float* NST = WSP(float, WS_NST);
    const bf16_t* P0 = WSP(bf16_t, WS_R1); bf16_t* CST = WSP(bf16_t, WS_R2);
    float igv[8], lfv[8];
#pragma unroll
    for (int i = 0; i < 8; ++i) { const int c = w + NWAVES * i; const size_t row = row_base + (size_t)(c < nchunk ? c : 0) * 64 + (lane < ntok ? lane : 0); igv[i] = GT[row * 8 + h]; lfv[i] = GT[row * 8 + 4 + h]; }
#pragma unroll
    for (int i = 0; i < 8; ++i) { const int c = w + NWAVES * i; if (c >= nchunk) break;
        const bool valid = lane < ntok; const size_t row = row_base + c * 64 + lane;
        const float ig = valid ? igv[i] : -INFINITY; const float lf = valid ? lfv[i] : 0.0f;
        float bc = lf;
#pragma unroll
        for (int o = 1; o < 64; o <<= 1) { const float t = __shfl_up(bc, o); if (lane >= o) bc += t; }
        const float Bc = __shfl(bc, 63);
        const float a = Bc - bc + ig;
        const float A = wave_max(a);
        ALOG[c * 64 + lane] = a;
        if (lane == 0) { AC[c] = A; BC[c] = Bc; }
        if (sl == 0 && valid) BCUM[row * 4 + h] = bc;
    }
    LBAR();
    if (w == 0) {
        float Bv = lane < nchunk ? BC[lane] : 0.0f, Av = lane < nchunk ? AC[lane] : -INFINITY; const float B0 = Bv;
#pragma unroll
        for (int o = 1; o < 64; o <<= 1) { const float Bp = __shfl_up(Bv, o), Ap = __shfl_up(Av, o); if (lane >= o) { Av = fmaxf(Ap + Bv, Av); Bv = Bp + Bv; } }
        const float mnext = fmaxf(m0 + Bv, Av); const float mprev = __shfl_up(mnext, 1); const float mcur = lane == 0 ? m0 : mprev;
        if (lane < nchunk) { MC[lane] = mcur; WST[lane] = expf(B0 + mcur - mnext); if (lane == nchunk - 1) MC[nchunk] = mnext; }
    }
    LBAR();
    if (sl == 0 && tid < nchunk) MST[ch0 + tid] = MC[tid];
    f32x4 acc[2]; float nreg = 0.0f;
    if (samp) {
#pragma unroll
        for (int vh = 0; vh < 2; ++vh) acc[vh] = *(const f32x4*)(F.in[2] + ((size_t)bh * MDV + 32 * sl + 16 * vh + fr) * MDK + 16 * w + 4 * fq);
        if (tid < 128) nreg = F.in[3][bh * MDK + tid];
    } else { acc[0] = (f32x4){0.f, 0.f, 0.f, 0.f}; acc[1] = acc[0]; }
    const int st_s = tid & 63, st_c = tid >> 6;
    const int st_sc = st_s < ntok ? st_s : ntok - 1;
    const bool st_ok = st_s < ntok;
    u32x4 kA[2], vA = (u32x4){0u, 0u, 0u, 0u}, kB[2], vB = (u32x4){0u, 0u, 0u, 0u};
#define M2_LOAD(KR, VR, c) do { \
        _Pragma("unroll") for (int i_ = 0; i_ < 2; ++i_) KR[i_] = *(const u32x4*)(P0 + (row_base + (size_t)(c) * 64 + st_sc) * NP0 + 512 + h * MDK + (st_c + 8 * i_) * 8); \
        if (tid < 256) VR = *(const u32x4*)(P0 + (row_base + (size_t)(c) * 64 + st_sc) * NP0 + 1024 + h * MDV + sl * 32 + st_c * 8); } while (0)
#define M2_CHUNK(KR, VR, c) do { \
        { bf16_t* cs = CST + (size_t)(ch0 + (c)) * (MDV * MDK); \
          _Pragma("unroll") for (int vh = 0; vh < 2; ++vh) { u32x2 pk; pk.x = cvt_pk_bf16(acc[vh][0], acc[vh][1]); pk.y = cvt_pk_bf16(acc[vh][2], acc[vh][3]); \
              *(u32x2*)(cs + (32 * sl + 16 * vh + fr) * MDK + 16 * w + 4 * fq) = pk; } \
          if (sl == 0 && tid < 128) NST[(size_t)(ch0 + (c)) * MDK + tid] = nreg; } \
        LBAR();                                                  \
        const float mnext = MC[(c) + 1]; \
        _Pragma("unroll") for (int i = 0; i < 2; ++i) { \
            _Pragma("unroll") for (int e = 0; e < 8; ++e) KT[((st_c + 8 * i) * 8 + e) * M2_PITCH + st_s] = st_ok ? (bf16_t)((KR[i][e >> 1] >> ((e & 1) * 16)) & 0xffffu) : (bf16_t)0; } \
        if (tid < 256) { const float wgt = st_ok ? expf(ALOG[(c) * 64 + st_s] - mnext) : 0.0f; \
            _Pragma("unroll") for (int e = 0; e < 8; ++e) { const unsigned wd = VR[e >> 1]; const float x = (e & 1) ? bfhi(wd) : bflo(wd); VT[(st_c * 8 + e) * M2_PITCH + st_s] = st_ok ? (bf16_t)(cvt_pk_bf16(x * wgt, 0.f) & 0xffffu) : (bf16_t)0; } } \
        if (tid < 64) WROW[tid] = expf(ALOG[(c) * 64 + tid] - mnext); \
        if ((c) + 2 < nchunk) M2_LOAD(KR, VR, (c) + 2); \
        LBAR(); \
        const float wst = WST[c]; \
        acc[0] = acc[0] * wst; acc[1] = acc[1] * wst; \
        _Pragma("unroll") for (int ks = 0; ks < 2; ++ks) { const bf16x8 bk = *(const LAS bf16x8*)(KT + (16 * w + fr) * M2_PITCH + 32 * ks + 8 * fq); \
            _Pragma("unroll") for (int vh = 0; vh < 2; ++vh) { const bf16x8 av = *(const LAS bf16x8*)(VT + (16 * vh + fr) * M2_PITCH + 32 * ks + 8 * fq); acc[vh] = MFMA16(bk, av, acc[vh]); } } \
        if (sl == 0 && tid < 128) { float ns = 0.f; \
            _Pragma("unroll") for (int sb = 0; sb < 8; ++sb) { const u32x4 kk = *(const LAS u32x4*)(KT + tid * M2_PITCH + 8 * sb); const f32x4 w0 = *(const LAS f32x4*)(WROW + 8 * sb), w1 = *(const LAS f32x4*)(WROW + 8 * sb + 4); \
                ns += bflo(kk.x) * w0.x + bfhi(kk.x) * w0.y + bflo(kk.y) * w0.z + bfhi(kk.y) * w0.w + bflo(kk.z) * w1.x + bfhi(kk.z) * w1.y + bflo(kk.w) * w1.z + bfhi(kk.w) * w1.w; } \
            nreg = nreg * wst + ns; } } while (0)
    M2_LOAD(kA, vA, 0);
    if (nchunk > 1) M2_LOAD(kB, vB, 1);
    for (int c = 0; c < nchunk; c += 2) {
        M2_CHUNK(kA, vA, c);
        if (c + 1 < nchunk) M2_CHUNK(kB, vB, c + 1);
    }
#undef M2_CHUNK
#undef M2_LOAD
    { float* oc = F.out + (samp ? O_SC : O_PC) + (size_t)bh * (MDV * MDK);
#pragma unroll
      for (int vh = 0; vh < 2; ++vh) *(f32x4*)(oc + (32 * sl + 16 * vh + fr) * MDK + 16 * w + 4 * fq) = acc[vh];
      if (sl == 0 && tid < 128) F.out[(samp ? O_SN : O_PN) + bh * MDK + tid] = nreg;
      if (sl == 0 && tid == 0) F.out[(samp ? O_SM : O_PM) + bh] = MC[nchunk]; }
    LBAR();
}
__device__ __forceinline__ void m2_phase(Frame& F) { for (int u = F.vcu; u < 768; u += F.G) m2_unit(F, u); }

constexpr int M3_KL = 0, M3_VL = 16384, M3_OST = 49152, M3_OPITCH = 260, M3_SM = 116736;
__device__ __forceinline__ void m3_unit(Frame& F, int u) {
    const bool samp = u >= NCH_P; const int bh = samp ? u - NCH_P : (u >> 6), c = samp ? 0 : (u & 63), b = bh >> 2, h = bh & 3;
    const int ntok = samp ? 16 : 64; const int ch = u;
    const size_t row_base = samp ? (size_t)TP + b * 16 : (size_t)b * PSEQ + c * 64;
    const int tid = F.tid, lane = F.lane, w = F.wave, r32 = lane & 31, hi = lane >> 5;
    LAS unsigned char* KL = F.lds + M3_KL; LAS unsigned char* VL = F.lds + M3_VL; LAS float* OST = (LAS float*)(F.lds + M3_OST);
    LAS float* ES2 = (LAS float*)(F.lds + M3_SM); LAS float* ET2 = ES2 + 64; LAS float* WINT = ES2 + 128; LAS float* EMM = ES2 + 192; LAS float* N0 = ES2 + 256; LAS float* RED = ES2 + 384;
    const float* GT = vptr(WSP(float, WS_GATES)); const float* BCUM = vptr(WSP(float, WS_BCUM)); const float* MST = WSP(float, WS_MST); const float* NST = vptr(WSP(float, WS_NST));
    const bf16_t* P0 = vptr(WSP(bf16_t, WS_R1)); const bf16_t* CST = vptr(WSP(bf16_t, WS_R2) + (size_t)ch * (MDV * MDK)); bf16_t* HM = vptr(WSP(bf16_t, WS_R3));
    const int th = w & 1, vq = w >> 1; const int t = 32 * th + r32; const bool tvalid = t < ntok;
    float sc_m0 = 0.f, sc_ig = 0.f, sc_bc = 0.f;
    if (w == 0) { const size_t row = row_base + (lane < ntok ? lane : ntok - 1); sc_m0 = MST[ch]; sc_ig = GT[row * 8 + h]; sc_bc = BCUM[row * 4 + h]; }
    const u32x4 zero4 = (u32x4){0u, 0u, 0u, 0u};
    u32x4 kst[2], vst[4];
#pragma unroll
    for (int i = 0; i < 2; ++i) { const int p = tid + 512 * i, s = p >> 4, cc = p & 15; const int sc = s < ntok ? s : ntok - 1;
        kst[i] = *(const u32x4*)(P0 + (row_base + sc) * NP0 + 512 + h * MDK + cc * 8); }
#pragma unroll
    for (int i = 0; i < 4; ++i) { const int p = tid + 512 * i, s = p >> 5, c0 = (p & 31) * 8; const int sc = s < ntok ? s : ntok - 1;
        vst[i] = *(const u32x4*)(P0 + (row_base + sc) * NP0 + 1024 + h * MDV + c0); }
    bf16x8 qf[8];
    { const int tc = tvalid ? t : ntok - 1;
#pragma unroll
      for (int d0 = 0; d0 < 8; ++d0) qf[d0] = *(const bf16x8*)(P0 + (row_base + tc) * NP0 + h * MDK + 16 * d0 + 8 * hi); }
    bf16x8 cfr[2][8];
#pragma unroll
    for (int db = 0; db < 2; ++db)
#pragma unroll
        for (int st = 0; st < 8; ++st) cfr[db][st] = *(const bf16x8*)(CST + (size_t)(32 * (vq * 2 + db) + r32) * MDK + 16 * st + 8 * hi);
    if (w == 0) {
        const bool valid = lane < ntok;
        const float m0 = sc_m0; const float ig = valid ? sc_ig : -INFINITY; const float bc = sc_bc;
        const float es = ig - bc; float pm = es;
#pragma unroll
        for (int o = 1; o < 64; o <<= 1) { const float tt_ = __shfl_up(pm, o); if (lane >= o) pm = fmaxf(pm, tt_); }
        const float m = bc + fmaxf(m0, pm);
        ES2[lane] = es * LOG2E; ET2[lane] = (bc - m) * LOG2E; WINT[lane] = expf(bc + m0 - m); EMM[lane] = expf(-m);
    }
    if (tid >= 64 && tid < 192) N0[tid - 64] = NST[(size_t)ch * MDK + tid - 64];
#pragma unroll
    for (int i = 0; i < 2; ++i) { const int p = tid + 512 * i, s = p >> 4, cc = p & 15;
        *(LAS u32x4*)(KL + cc * 1024 + s * 16) = (s < ntok) ? kst[i] : zero4; }
#pragma unroll
    for (int i = 0; i < 4; ++i) { const int p = tid + 512 * i, s = p >> 5, c0 = (p & 31) * 8;
        *(LAS u32x4*)(VL + (c0 >> 5) * 4096 + (s >> 4) * 1024 + (s & 15) * 64 + (c0 & 31) * 2) = (s < ntok) ? vst[i] : zero4; }
    if (!tvalid) {
#pragma unroll
        for (int d0 = 0; d0 < 8; ++d0) qf[d0] = (bf16x8){0, 0, 0, 0, 0, 0, 0, 0}; }
    LBAR();
    const float et2 = ET2[t], wint = WINT[t], emm = EMM[t];
    f32x16 X0 = {}, X1 = {};
#pragma unroll
    for (int d0 = 0; d0 < 8; ++d0) { const bf16x8 k0 = *(const LAS bf16x8*)(KL + (2 * d0 + hi) * 1024 + r32 * 16); X0 = MFMA32(k0, qf[d0], X0);
        if (th) { const bf16x8 k1 = *(const LAS bf16x8*)(KL + (2 * d0 + hi) * 1024 + 512 + r32 * 16); X1 = MFMA32(k1, qf[d0], X1); } }
    float cs = 0.f;
#pragma unroll
    for (int r4 = 0; r4 < 4; ++r4) { const f32x4 e0 = *(const LAS f32x4*)(ES2 + 8 * r4 + 4 * hi), e1 = *(const LAS f32x4*)(ES2 + 32 + 8 * r4 + 4 * hi);
#pragma unroll
        for (int i = 0; i < 4; ++i) { const int r = 4 * r4 + i, s = 8 * r4 + 4 * hi + i;
            const float w0 = (s <= t) ? __builtin_amdgcn_exp2f(et2 + e0[i]) : 0.f; X0[r] *= w0; cs += X0[r];
            if (th) { const float w1 = (s + 32 <= t) ? __builtin_amdgcn_exp2f(et2 + e1[i]) : 0.f; X1[r] *= w1; cs += X1[r]; } } }
    cs = swap_add(cs);
    float qn = 0.f;
#pragma unroll
    for (int d0 = 0; d0 < 8; ++d0) { const f32x4 n0 = *(const LAS f32x4*)(N0 + 16 * d0 + 8 * hi), n1 = *(const LAS f32x4*)(N0 + 16 * d0 + 8 * hi + 4); const u32x4 q = __builtin_bit_cast(u32x4, qf[d0]);
        qn += bflo(q.x) * n0.x + bfhi(q.x) * n0.y + bflo(q.y) * n0.z + bfhi(q.y) * n0.w + bflo(q.z) * n1.x + bfhi(q.z) * n1.y + bflo(q.w) * n1.z + bfhi(q.w) * n1.w; }
    qn = swap_add(qn);
    const float den = wint * qn + cs; const float inv = 1.0f / fmaxf(fabsf(den), emm);
    bf16x8 pf[4]; pf[0] = pack8(X0, 0); pf[1] = pack8(X0, 1); pf[2] = pack8(X1, 0); pf[3] = pack8(X1, 1);
    LAS const unsigned char* vb0 = VL + ((lane >> 4) & 1) * 32 + (lane & 3) * 8 + (4 * hi + ((lane & 15) >> 2)) * 64;
    f32x16 o[2]; float ssq = 0.f;
#pragma unroll
    for (int db = 0; db < 2; ++db) { const int vb = vq * 2 + db; f32x16 a = {};
#pragma unroll
        for (int st = 0; st < 8; ++st) a = MFMA32(cfr[db][st], qf[st], a);
#pragma unroll
        for (int r = 0; r < 16; ++r) a[r] *= wint;
#pragma unroll
        for (int ks = 0; ks < 4; ++ks) if (ks < 2 || th) { const s16x4 lo = vtr(vb0 + vb * 4096 + ks * 1024), hh = vtr(vb0 + vb * 4096 + ks * 1024 + 512); a = MFMA32(mk_vfrag(lo, hh), pf[ks], a); }
#pragma unroll
        for (int r = 0; r < 16; ++r) { a[r] *= inv; ssq += a[r] * a[r]; }
        o[db] = a; }
    ssq = swap_add(ssq);
    if (hi == 0) RED[vq * 64 + t] = ssq;
    const float* gh = vptr(F.in[10] + h * MDV);
    u32x4 ogr[4]; f32x4 g0r[4], g1r[4];
#pragma unroll
    for (int i = 0; i < 4; ++i) { const int p = tid + 512 * i, tt = p >> 5, c8 = (p & 31) * 8; const int tc = tt < ntok ? tt : ntok - 1;
        ogr[i] = *(const u32x4*)(P0 + (row_base + tc) * NP0 + 2048 + h * MDV + c8); g0r[i] = *(const f32x4*)(gh + c8); g1r[i] = *(const f32x4*)(gh + c8 + 4); }
    LBAR();
    const float rstd = 1.0f / sqrtf((RED[t] + RED[64 + t] + RED[128 + t] + RED[192 + t]) * (1.0f / MDV) + EPS);
#pragma unroll
    for (int db = 0; db < 2; ++db)
#pragma unroll
        for (int r4 = 0; r4 < 4; ++r4) { const f32x4 v = (f32x4){o[db][4 * r4], o[db][4 * r4 + 1], o[db][4 * r4 + 2], o[db][4 * r4 + 3]} * rstd;
            *(LAS f32x4*)(OST + t * M3_OPITCH + 32 * (vq * 2 + db) + 8 * r4 + 4 * hi) = v; }
    LBAR();
#pragma unroll
    for (int i = 0; i < 4; ++i) { const int p = tid + 512 * i, tt = p >> 5, c8 = (p & 31) * 8;
        if (tt < ntok) { const f32x4 a0 = *(const LAS f32x4*)(OST + tt * M3_OPITCH + c8), a1 = *(const LAS f32x4*)(OST + tt * M3_OPITCH + c8 + 4);
            const f32x4 g0 = g0r[i], g1 = g1r[i]; const u32x4 og = ogr[i];
            u32x4 r; r.x = cvt_pk_bf16(a0.x * g0.x * bflo(og.x), a0.y * g0.y * bfhi(og.x)); r.y = cvt_pk_bf16(a0.z * g0.z * bflo(og.y), a0.w * g0.w * bfhi(og.y));
            r.z = cvt_pk_bf16(a1.x * g1.x * bflo(og.z), a1.y * g1.y * bfhi(og.z)); r.w = cvt_pk_bf16(a1.z * g1.z * bflo(og.w), a1.w * g1.w * bfhi(og.w));
            *(u32x4*)(HM + (row_base + tt) * DM + h * MDV + c8) = r; } }
    LBAR();
}
__device__ __forceinline__ void m3_phase(Frame& F) { for (int u = F.vcu; u < NCH_ALL; u += F.G) m3_unit(F, u); }

constexpr int AT_BUF = 32768, AT_K0 = 0, AT_K1 = 8192, AT_V = 16384, AT_OUTS = 65536, AT_OPITCH = 272, AT_BTAB = 131072, AT_GH = 132096, AT_LAM = 132608, AT_QL = 133120, AT_NSLOT = 4;
__device__ __forceinline__ int t5_bucket(int rel) {
    const int n = rel < 0 ? -rel : rel; const int ret = rel > 0 ? 16 : 0;
    int large = 8 + (int)(logf(fmaxf((float)n, 1.0f) * 0.125f) / logf(16.0f) * 8.0f + 1e-5f);
    large = large < 15 ? large : 15;
    return ret + (n < 8 ? n : large);
}
template <bool SAMP, int DIAG = 0>
__device__ __forceinline__ void attn_unit(Frame& F, int b, int h, int q0, float lam) {
    const int tid = F.tid, lane = F.lane, w = F.wave, r32 = lane & 31, hi = lane >> 5;
    const int j = w >> 2, qs = w & 3;
    const bf16_t* KVQ = WSP(bf16_t, WS_R1); bf16_t* AO = DIAG ? WSP(bf16_t, WS_R2) : WSP(bf16_t, WS_R3);
    const size_t rowbase = SAMP ? (size_t)TP + b * 16 : (size_t)b * PSEQ;
    const int ntile = SAMP ? 33 : (q0 >> 6) + 2;
    const int qpos0 = SAMP ? PAST : q0;
    const int nq = SAMP ? 16 : 128;
    LAS float* BTAB = (LAS float*)(F.lds + AT_BTAB); LAS float* GH = (LAS float*)(F.lds + AT_GH);
    const int rel_ = (tid & 255) - 192;
    const float bt_a = F.in[14][t5_bucket(rel_) * 8 + h], bt_b = F.in[14][15 * 8 + h];
    const float ghv = F.in[20][tid & 127];
    const int qrow = 32 * qs + r32; const bool qvalid = qrow < nq;
    bf16x8 qf[4];
#pragma unroll
    for (int d0 = 0; d0 < 4; ++d0) qf[d0] = *(const bf16x8*)(KVQ + (rowbase + q0 + (qvalid ? qrow : 0)) * 3072 + 2048 + h * 128 + j * 64 + 16 * d0 + 8 * hi);
    const unsigned dko = (unsigned)(((rowbase + 8 * w + (lane >> 3)) * 3072 + h * 128 + (((lane & 7) ^ (((8 * w + (lane >> 3)) >> 1) & 7)) * 8)) * 2);
    const unsigned dvo = (unsigned)(((rowbase + 16 * ((2 * w) & 3) + (lane >> 2)) * 3072 + 1024 + h * 128 + ((2 * w) >> 2) * 32 + (lane & 3) * 8) * 2);
    const unsigned lds0 = (unsigned)(uintptr_t)F.lds;
#define AT_DMA(kt, slot) do { const char* tb_ = (const char*)KVQ + (size_t)(kt) * (64 * 3072 * 2); const unsigned B_ = lds0 + (slot) * AT_BUF; \
        glds16s(tb_, dko, (unsigned)__builtin_amdgcn_readfirstlane(B_ + AT_K0 + w * 1024)); \
        glds16s(tb_ + 128, dko, (unsigned)__builtin_amdgcn_readfirstlane(B_ + AT_K1 + w * 1024)); \
        glds16s(tb_, dvo, (unsigned)__builtin_amdgcn_readfirstlane(B_ + AT_V + (2 * w) * 1024)); \
        glds16s(tb_ + 16 * 3072 * 2, dvo, (unsigned)__builtin_amdgcn_readfirstlane(B_ + AT_V + (2 * w + 1) * 1024)); } while (0)
    if (!SAMP && !(DIAG & 1)) { AT_DMA(0, 0); AT_DMA(1, 1); }
    if (tid < 256) BTAB[tid] = (bt_a - bt_b) * LOG2E;
    if (tid >= 256 && tid < 384) GH[tid - 256] = ghv;
    if (!qvalid) { qf[0] = (bf16x8){0, 0, 0, 0, 0, 0, 0, 0}; qf[1] = qf[0]; qf[2] = qf[0]; qf[3] = qf[0]; }
    LAS unsigned char* qlane = F.lds + AT_QL + w * 3072 + lane * 16;
    *(LAS bf16x8*)qlane = qf[1]; *(LAS bf16x8*)(qlane + 1024) = qf[2]; *(LAS bf16x8*)(qlane + 2048) = qf[3];
    const int qpos = qpos0 + qrow;
    const int cq = SAMP ? 32 : ((q0 + 32 * qs) >> 6);
    const bool wactive = SAMP ? (qs == 0) : true;
    const float* ck = F.in[5]; const float* cv = F.in[6]; const float* nk = F.out + O_SK; const float* nv = F.out + O_SV;
    const int lt = ((w & 3) - 1 + 3 * (w >> 2)) * 64 + lane;
#define AT_SLOAD(kt, slot) do { LAS unsigned char* B_ = F.lds + (slot) * AT_BUF; f32x4 fa[6], fb[6]; \
        _Pragma("unroll") for (int i_ = 0; i_ < 6; ++i_) { int p_ = lt + 384 * i_; p_ = p_ < 2048 ? p_ : 2047; const int row_ = p_ >> 5, c_ = p_ & 31; int kv_ = (kt) * 64 + row_; kv_ = kv_ < PAST + 16 ? kv_ : PAST + 15; \
            const float* src_ = (c_ < 16) ? (kv_ < PAST ? ck + ((size_t)b * PAST + kv_) * 1024 : nk + ((size_t)b * 16 + (kv_ - PAST)) * 1024) + h * 128 + c_ * 8 \
                                          : (kv_ < PAST ? cv + ((size_t)b * PAST + kv_) * 1024 : nv + ((size_t)b * 16 + (kv_ - PAST)) * 1024) + h * 128 + (c_ - 16) * 8; \
            fa[i_] = *(const f32x4*)src_; fb[i_] = *(const f32x4*)(src_ + 4); } \
        _Pragma("unroll") for (int i_ = 0; i_ < 6; ++i_) { const int p_ = lt + 384 * i_; const int row_ = (p_ >> 5) & 63, c_ = p_ & 31; \
            const int off_ = (c_ < 8) ? AT_K0 + row_ * 128 + ((c_ ^ ((row_ >> 1) & 7)) * 16) : (c_ < 16) ? AT_K1 + row_ * 128 + (((c_ - 8) ^ ((row_ >> 1) & 7)) * 16) : AT_V + ((c_ - 16) >> 2) * 4096 + (row_ >> 4) * 1024 + (row_ & 15) * 64 + ((c_ - 16) & 3) * 16; \
            const u32x4 v_ = (u32x4){cvt_pk_bf16(fa[i_].x, fa[i_].y), cvt_pk_bf16(fa[i_].z, fa[i_].w), cvt_pk_bf16(fb[i_].x, fb[i_].y), cvt_pk_bf16(fb[i_].z, fb[i_].w)}; \
            if (p_ < 2048) *(LAS u32x4*)(B_ + off_) = v_; } } while (0)
    if (SAMP && qs != 0) {
        AT_SLOAD(0, 0);
        __syncthreads();
        int sl = 0;
        for (int kt = 0; kt < ntile; ++kt) { const int sln = (sl + 1) & 3; if (kt + 1 < ntile) AT_SLOAD(kt + 1, sln); __syncthreads(); sl = sln; }
        __syncthreads(); __syncthreads();
    } else {
    f32x16 o[4]; o[0] = f32x16{}; o[1] = f32x16{}; o[2] = f32x16{}; o[3] = f32x16{};
    float mrun = -INFINITY, lrun = 0.f;
    bf16x8 pf[4];
    const int qmin = qpos0 + 32 * qs;
    LAS const unsigned char* vlane = F.lds + AT_V + ((lane >> 4) & 1) * 32 + (lane & 3) * 8 + (4 * hi + ((lane & 15) >> 2)) * 64;
    LAS const unsigned char* klane = F.lds + (j ? AT_K1 : AT_K0) + r32 * 128; const int kswz = (r32 >> 1) & 7;
    int kofs[4];
#pragma unroll
    for (int d0 = 0; d0 < 4; ++d0) kofs[d0] = ((2 * d0 + hi) ^ kswz) * 16;
#define TRR(dst, addr, off) asm volatile("ds_read_b64_tr_b16 %0, %1 offset:%c2" : "=&v"(dst) : "v"(addr), "i"(off) : "memory")
#define AT_VRD(V, db) do { _Pragma("unroll") for (int ks_ = 0; ks_ < 4; ++ks_) { TRR(V[2 * ks_], vaddr, (db) * 4096 + ks_ * 1024); TRR(V[2 * ks_ + 1], vaddr, (db) * 4096 + ks_ * 1024 + 512); } } while (0)
#define AT_EXP2(P, a) do { if (WE_ && !(DIAG & 8)) { P[a] = __builtin_amdgcn_exp2f(P[a] - mnew); P[(a) + 1] = __builtin_amdgcn_exp2f(P[(a) + 1] - mnew); asm volatile("" : "+v"(P[a]), "+v"(P[(a) + 1])); } } while (0)
#define AT_PVBLK(db, V, P, a) do { \
        o[db] = MFMA32(mk_vfrag(V[0], V[1]), pf[0], o[db]); AT_EXP2(P, a); __builtin_amdgcn_sched_barrier(0); \
        o[db] = MFMA32(mk_vfrag(V[2], V[3]), pf[1], o[db]); AT_EXP2(P, (a) + 2); __builtin_amdgcn_sched_barrier(0); \
        o[db] = MFMA32(mk_vfrag(V[4], V[5]), pf[2], o[db]); AT_EXP2(P, (a) + 4); __builtin_amdgcn_sched_barrier(0); \
        o[db] = MFMA32(mk_vfrag(V[6], V[7]), pf[3], o[db]); AT_EXP2(P, (a) + 6); __builtin_amdgcn_sched_barrier(0); } while (0)
#define AT_STEP(kt, slk, slv, DO_QK, DO_PV) do { constexpr bool WE_ = DO_QK; \
        f32x16 X0 = {}, X1 = {}; bool need = false; float alpha = 1.0f, mnew = mrun; \
        if (DO_QK) { LAS const unsigned char* KB_ = klane + (slk) * AT_BUF; \
            _Pragma("unroll") for (int d0 = 0; d0 < 4; ++d0) { const int ko_ = kofs[d0]; const bf16x8 k0 = *(const LAS bf16x8*)(KB_ + ko_), k1 = *(const LAS bf16x8*)(KB_ + ko_ + 4096); \
                const bf16x8 qd = d0 == 0 ? qf[0] : *(const LAS bf16x8*)(qlane + (d0 - 1) * 1024); X0 = MFMA32(k0, qd, X0); X1 = MFMA32(k1, qd, X1); } \
            asm volatile("s_nop 15\n\ts_nop 7" : "+v"(X0), "+v"(X1));        \
            if ((kt) * 64 + 63 + 91 > qmin) { const int base = (kt) * 64 + 4 * hi - qpos + 192;        \
                _Pragma("unroll") for (int r = 0; r < 16; ++r) { X0[r] += BTAB[base + (r & 3) + 8 * (r >> 2)]; X1[r] += BTAB[base + (r & 3) + 8 * (r >> 2) + 32]; } } \
            if (SAMP && (kt) == 32) { _Pragma("unroll") for (int r = 0; r < 16; ++r) { if (crow(r, hi) >= 16) X0[r] = -INFINITY; X1[r] = -INFINITY; } } \
            if ((kt) > cq) { _Pragma("unroll") for (int r = 0; r < 16; ++r) { X0[r] = -INFINITY; X1[r] = -INFINITY; } }        \
            float ma = max3f(X0[0], X0[1], X1[0]), mb = max3f(X0[2], X0[3], X1[1]); ma = max3f(ma, X1[2], X1[3]); \
            _Pragma("unroll") for (int r = 4; r < 16; r += 4) { ma = max3f(ma, X0[r], X0[r + 1]); mb = max3f(mb, X0[r + 2], X0[r + 3]); ma = max3f(ma, X1[r], X1[r + 1]); mb = max3f(mb, X1[r + 2], X1[r + 3]); } \
            float mx = max3f(ma, mb, mb); mx = swap_max(mx); \
            need = __any(mx > mrun + 8.0f) != 0; \
            mnew = need ? fmaxf(mrun, mx) : mrun; alpha = __builtin_amdgcn_exp2f(mrun - mnew); mrun = mnew; } \
        __builtin_amdgcn_sched_barrier(0); \
        if (DO_PV) { const unsigned vaddr = (unsigned)(uintptr_t)(vlane + (slv) * AT_BUF); s16x4 va[8], vb[8]; \
            AT_VRD(va, 0); AT_VRD(vb, 1); asm volatile("s_waitcnt lgkmcnt(8)" ::: "memory"); __builtin_amdgcn_sched_barrier(0); \
            AT_PVBLK(0, va, X0, 0); \
            AT_VRD(va, 2); asm volatile("s_waitcnt lgkmcnt(8)" ::: "memory"); __builtin_amdgcn_sched_barrier(0); \
            AT_PVBLK(1, vb, X0, 8); \
            AT_VRD(vb, 3); asm volatile("s_waitcnt lgkmcnt(8)" ::: "memory"); __builtin_amdgcn_sched_barrier(0); \
            AT_PVBLK(2, va, X1, 0); \
            asm volatile("s_waitcnt lgkmcnt(0)" ::: "memory"); __builtin_amdgcn_sched_barrier(0); \
            AT_PVBLK(3, vb, X1, 8); } \
        else if (DO_QK) { _Pragma("unroll") for (int r = 0; r < 16; ++r) { X0[r] = __builtin_amdgcn_exp2f(X0[r] - mnew); X1[r] = __builtin_amdgcn_exp2f(X1[r] - mnew); } } \
        if (DO_QK) { if (need) { _Pragma("unroll") for (int db = 0; db < 4; ++db) _Pragma("unroll") for (int r = 0; r < 16; ++r) o[db][r] *= alpha; } \
            float ps = 0.f; _Pragma("unroll") for (int r = 0; r < 16; ++r) ps += X0[r] + X1[r]; \
            lrun = lrun * alpha + ps; pf[0] = pack8(X0, 0); pf[1] = pack8(X0, 1); pf[2] = pack8(X1, 0); pf[3] = pack8(X1, 1); } } while (0)
    f32x16 X0 = {}, X1 = {}; bool need = false; float alpha = 1.0f, mnew = -INFINITY;
#define AT_SUMPACK() do { float pa_ = X0[0] + X1[0], pb_ = X0[1] + X1[1], pc_ = X0[2] + X1[2], pd_ = X0[3] + X1[3]; \
        _Pragma("unroll") for (int r = 4; r < 16; r += 4) { pa_ += X0[r] + X1[r]; pb_ += X0[r + 1] + X1[r + 1]; pc_ += X0[r + 2] + X1[r + 2]; pd_ += X0[r + 3] + X1[r + 3]; } lrun += (pa_ + pb_) + (pc_ + pd_); \
        pf[0] = pack8(X0, 0); pf[1] = pack8(X0, 1); pf[2] = pack8(X1, 0); pf[3] = pack8(X1, 1); } while (0)
#define AT_H1(kt, slk, HASPREV) do { if (HASPREV && !(DIAG & 16)) AT_SUMPACK(); \
        { LAS const unsigned char* KB_ = klane + (slk) * AT_BUF; X0 = f32x16{}; X1 = f32x16{}; \
            _Pragma("unroll") for (int d0 = 0; d0 < 4; ++d0) { const int ko_ = kofs[d0]; const bf16x8 k0 = *(const LAS bf16x8*)(KB_ + ko_), k1 = *(const LAS bf16x8*)(KB_ + ko_ + 4096); \
                const bf16x8 qd = d0 == 0 ? qf[0] : *(const LAS bf16x8*)(qlane + (d0 - 1) * 1024); X0 = MFMA32(k0, qd, X0); X1 = MFMA32(k1, qd, X1); } \
            asm volatile("s_nop 15\n\ts_nop 7" : "+v"(X0), "+v"(X1)); \
            if ((kt) * 64 + 63 + 91 > qmin) { const int base = (kt) * 64 + 4 * hi - qpos + 192; \
                _Pragma("unroll") for (int r = 0; r < 16; ++r) { X0[r] += BTAB[base + (r & 3) + 8 * (r >> 2)]; X1[r] += BTAB[base + (r & 3) + 8 * (r >> 2) + 32]; } } \
            if (__builtin_expect((kt) > cq, 0)) { asm volatile("; tile not visible to this wave" ::: "memory"); _Pragma("unroll") for (int r = 0; r < 16; ++r) { X0[r] = -INFINITY; X1[r] = -INFINITY; } } \
            float ma = max3f(X0[0], X0[1], X1[0]), mb = max3f(X0[2], X0[3], X1[1]); ma = max3f(ma, X1[2], X1[3]); \
            _Pragma("unroll") for (int r = 4; r < 16; r += 4) { ma = max3f(ma, X0[r], X0[r + 1]); mb = max3f(mb, X0[r + 2], X0[r + 3]); ma = max3f(ma, X1[r], X1[r + 1]); mb = max3f(mb, X1[r + 2], X1[r + 3]); } \
            float mx = max3f(ma, mb, mb); mx = swap_max(mx); \
            need = __any(mx > mrun + 8.0f) != 0; \
            mnew = need ? fmaxf(mrun, mx) : mrun; alpha = __builtin_amdgcn_exp2f(mrun - mnew); mrun = mnew; } } while (0)
#define AT_PV4(slv, WE) do { constexpr bool WE_ = WE; const unsigned vaddr = (unsigned)(uintptr_t)(vlane + (slv) * AT_BUF); s16x4 va[8], vb[8]; \
            AT_VRD(va, 0); AT_VRD(vb, 1); asm volatile("s_waitcnt lgkmcnt(8)" ::: "memory"); __builtin_amdgcn_sched_barrier(0); \
            AT_PVBLK(0, va, X0, 0); \
            AT_VRD(va, 2); asm volatile("s_waitcnt lgkmcnt(8)" ::: "memory"); __builtin_amdgcn_sched_barrier(0); \
            AT_PVBLK(1, vb, X0, 8); \
            AT_VRD(vb, 3); asm volatile("s_waitcnt lgkmcnt(8)" ::: "memory"); __builtin_amdgcn_sched_barrier(0); \
            AT_PVBLK(2, va, X1, 0); \
            asm volatile("s_waitcnt lgkmcnt(0)" ::: "memory"); __builtin_amdgcn_sched_barrier(0); \
            AT_PVBLK(3, vb, X1, 8); } while (0)
#define AT_H2(slv, HASPREV) do { if (HASPREV && !(DIAG & 4)) AT_PV4(slv, true); \
        else { _Pragma("unroll") for (int r = 0; r < 16; ++r) { X0[r] = __builtin_amdgcn_exp2f(X0[r] - mnew); X1[r] = __builtin_amdgcn_exp2f(X1[r] - mnew); } } \
        if (need) { _Pragma("unroll") for (int db = 0; db < 4; ++db) _Pragma("unroll") for (int r = 0; r < 16; ++r) o[db][r] *= alpha; } \
        lrun *= alpha; } while (0)
#define AT_FIN(slv) do { AT_SUMPACK(); if (!(DIAG & 4)) AT_PV4(slv, false); } while (0)
#define AT_WAITBAR(N) asm volatile("s_waitcnt vmcnt(" #N ") lgkmcnt(0)\n\ts_barrier" ::: "memory")
    if (SAMP) {
        __syncthreads();
        int sl = 0;
        for (int kt = 0; kt < ntile; ++kt) {
            const int slp = (sl + 3) & 3;
            if (kt == 0) AT_STEP(kt, sl, slp, true, false); else AT_STEP(kt, sl, slp, true, true);
            __syncthreads();
            sl = (sl + 1) & 3;
        }
        { const int sll = (sl + 3) & 3; AT_STEP(0, 0, sll, false, true); }
    } else {
        AT_WAITBAR(4);
#define AT_BAR() asm volatile("s_waitcnt lgkmcnt(0)\n\ts_barrier" ::: "memory")
        if (j) AT_BAR();
        if (!(DIAG & 2)) AT_H1(0, 0, false);
        AT_WAITBAR(0);
        if (!(DIAG & 1) && ntile > 2) AT_DMA(2, 2);
        if (!(DIAG & 2)) AT_H2(3, false);
        AT_BAR();
        for (int t = 1; t < ntile; ++t) {
            if (!(DIAG & 2)) AT_H1(t, t & 3, true);
            AT_WAITBAR(0);
            if (!(DIAG & 1) && t + 2 < ntile) AT_DMA(t + 2, (t + 2) & 3);
            if (!(DIAG & 2)) AT_H2((t + 3) & 3, true);
            AT_BAR();
        }
        if (!(DIAG & 2)) AT_FIN((ntile + 3) & 3);
        if (!j) AT_BAR();
#undef AT_BAR
    }
#undef AT_WAITBAR
#undef AT_DMA
#undef AT_STEP
#undef AT_H1
#undef AT_H2
#undef AT_FIN
#undef AT_PV4
#undef AT_SUMPACK
#undef AT_PVBLK
#undef AT_EXP2
#undef AT_VRD
#undef TRR
#undef AT_STAGE
#undef AT_DMA
#undef AT_SLOAD
#undef AT_DMA
    const float inv = 1.0f / swap_add(lrun);
    __syncthreads();
    LAS float* STG = (LAS float*)F.lds;
    if (j == 1) {
        const float f = -lam * inv;
#pragma unroll
        for (int db = 0; db < 4; ++db)
#pragma unroll
            for (int r = 0; r < 16; ++r) STG[(qs * 64 + db * 16 + r) * 64 + lane] = o[db][r] * f;
    }
    __syncthreads();
    if (j == 0) {
        float ssq = 0.f;
#pragma unroll
        for (int db = 0; db < 4; ++db)
#pragma unroll
            for (int r = 0; r < 16; ++r) { const float v = o[db][r] * inv + STG[(qs * 64 + db * 16 + r) * 64 + lane]; o[db][r] = v; ssq += v * v; }
        ssq = swap_add(ssq);
        const float rs = (1.0f - LAM_INIT) / sqrtf(ssq * (1.0f / 128.0f) + EPS);
        int dl = 4 * hi; asm volatile("" : "+v"(dl));
        LAS const float* ghp = GH + dl; LAS unsigned char* outp = F.lds + AT_OUTS + (32 * qs + r32) * AT_OPITCH + dl * 2;
#pragma unroll
        for (int db = 0; db < 4; ++db)
#pragma unroll
            for (int r4 = 0; r4 < 4; ++r4) { const f32x4 g = *(const LAS f32x4*)(ghp + 32 * db + 8 * r4);
                u32x2 pk; pk.x = cvt_pk_bf16(o[db][4 * r4] * rs * g.x, o[db][4 * r4 + 1] * rs * g.y); pk.y = cvt_pk_bf16(o[db][4 * r4 + 2] * rs * g.z, o[db][4 * r4 + 3] * rs * g.w);
                *(LAS u32x2*)(outp + (32 * db + 8 * r4) * 2) = pk; }
    }
    }
    __syncthreads();
    { LAS const unsigned char* OUTS = F.lds + AT_OUTS;
#pragma unroll
      for (int i = 0; i < 4; ++i) { const int p = tid + 512 * i, tt = p >> 4, c8 = (p & 15) * 8;
          if (tt < nq) *(u32x4*)(AO + (rowbase + q0 + tt) * DM + h * 128 + c8) = *(const LAS u32x4*)(OUTS + tt * AT_OPITCH + c8 * 2); } }
    if (!SAMP && DIAG == 0) {
        float* pk = F.out + O_PK + ((size_t)b * PSEQ + q0) * 1024 + h * 128; float* pv = F.out + O_PV + ((size_t)b * PSEQ + q0) * 1024 + h * 128;
        const bf16_t* src = KVQ + (rowbase + q0) * 3072 + h * 128;
#pragma unroll 1
        for (int i = 0; i < 8; ++i) { int p = tid + 512 * i; asm volatile("" : "+v"(p)); const int row = p >> 5, c = p & 31;
            const u32x4 wv = *(const u32x4*)(src + (size_t)row * 3072 + (c < 16 ? c * 8 : 1024 + (c - 16) * 8));
            float* d = (c < 16 ? pk + c * 8 : pv + (c - 16) * 8) + (size_t)row * 1024;
            *(f32x4*)d = (f32x4){bflo(wv.x), bfhi(wv.x), bflo(wv.y), bfhi(wv.y)}; *(f32x4*)(d + 4) = (f32x4){bflo(wv.z), bfhi(wv.z), bflo(wv.w), bfhi(wv.w)}; }
    }
    __syncthreads();
}
__device__ __forceinline__ void attn_phase(Frame& F, bool do_prompt, bool do_sample) {
    LAS float* LAMW = (LAS float*)(F.lds + AT_LAM);
    if (F.wave == 0) { const float s1 = wave_sum(F.in[16][F.lane] * F.in[17][F.lane]), s2 = wave_sum(F.in[18][F.lane] * F.in[19][F.lane]);
        if (F.lane == 0) LAMW[0] = expf(s1) - expf(s2) + LAM_INIT; }
    __syncthreads();
    const float lam = LAMW[0];
    if (do_prompt)
    for (int v = F.vcu; v < 256; v += F.G) { const int x = v >> 5, i = v & 31;
        for (int r = 0; r < 8; ++r) { const int bh = 8 * x + r, qb = (r & 1) ? 31 - i : i; attn_unit<false>(F, bh >> 3, bh & 7, qb * 128, lam); } }
    if (do_prompt && F.G == 256 && F.vcu >= 128) {
        unsigned* gcnt = (unsigned*)(F.ctl + CW_GRP + 64 * (F.vcu >> 5)); unsigned* gbar = (unsigned*)(F.ctl + CW_BAR);
        asm volatile("s_waitcnt vmcnt(0)" ::: "memory");
        __syncthreads();
        if (F.tid == 0) {
            __builtin_amdgcn_fence(__ATOMIC_RELEASE, "agent"); asm volatile("s_waitcnt vmcnt(0)" ::: "memory");
            (void)xb_add(gcnt, 1u); XB_SPIN(xb_ld(gcnt) < 32u, gbar);
            __builtin_amdgcn_fence(__ATOMIC_ACQUIRE, "agent"); asm volatile("s_waitcnt vmcnt(0)" ::: "memory");
        }
        __syncthreads();
        pg8::Gemm g{WSP(bf16_t, WS_R3), WSP(bf16_t, WS_WO1), TP, 1024, 1024}; pg8::SubOrder S; S.S.init(TP, 1024, F.G, (int)blockIdx.x); S.i0 = 0; S.n = 2;
        pg8::EpiBf16T E{WSP(bf16_t, WS_R2), 1024, 0, 0, 1.0f, 1 << 30};
        pg8::gemm_phase<pg8::EpiBf16T, pg8::SubOrder, true, true>(F.lds, g, S, E);
        __syncthreads();
    }
    if (do_prompt) {
        const bool all = F.G < 256; const int wk = all ? F.vcu : F.vcu - 128, nwk = all ? F.G : 128;
        if (all || (F.vcu >= 128 && F.vcu < 256)) { LAS float* scr = (LAS float*)(F.lds + F.wave * 16384);
            for (int r = (WC_LATE - WC_TAIL) + wk * NWAVES + F.wave; r < WC_LATE; r += nwk * NWAVES) { const WcItem t = wc_late_item(F, r); wconv_item(t.W, t.ldw, t.srccol0, t.gain, t.WT, t.K, t.dstrow0, t.k0, scr, F.lane); } }
    }
    if (do_sample)
    for (int v = F.vcu; v < 128; v += F.G) attn_unit<true>(F, v >> 3, v & 7, 0, lam);
}
#ifdef DIAGV
__device__ __forceinline__ void attn_phase_diag(Frame& F) {
    for (int v = F.vcu; v < 256; v += F.G) { const int x = v >> 5, i = v & 31;
        for (int r = 0; r < 8; ++r) { const int bh = 8 * x + r, qb = (r & 1) ? 31 - i : i; attn_unit<false, DIAGV>(F, bh >> 3, bh & 7, qb * 128, 0.5f); } }
}
#endif
constexpr int N_PHASES = 16;
struct Args { const float* in[24]; float* out; unsigned char* ws; int ph_lo, ph_hi; };
__global__ void __launch_bounds__(NWAVES * 64, 2) mk_fwd(Args args) {
    extern __shared__ __attribute__((aligned(16))) unsigned char lds[];
    Frame F;
    F.lds = (LAS unsigned char*)lds;
    F.MISC = (volatile LAS unsigned*)(F.lds + MISC_OFF);
    F.tid = threadIdx.x; F.lane = F.tid & 63; F.wave = __builtin_amdgcn_readfirstlane(F.tid >> 6);
    F.G = gridDim.x; { const int bx = blockIdx.x; F.vcu = (F.G % 8 == 0) ? (bx % 8) * (F.G / 8) + bx / 8 : bx; }
    F.in = (kargp_t)args.in;
    F.out = args.out; F.ws = args.ws; F.ctl = (gu32*)(args.ws + WS_CTL);
    for (int u = F.tid; u < (LDS_BYTES - LDSCTL_OFF) / 4; u += NWAVES * 64) ((LAS unsigned*)(F.lds + LDSCTL_OFF))[u] = 0u;
    __syncthreads();
    XcdBarrier bar; bar.bar = (unsigned*)(F.ctl + CW_BAR); bar.x = 0; bar.st = nullptr;
    if (MK_N_LAUNCHES == 1) bar = xcd_barrier_post((unsigned*)(F.ctl + CW_BAR), F.MISC + 8);
    const int lo = args.ph_lo, hi = args.ph_hi;
#ifndef PH_MASK
#define PH_MASK 0x7ffff
#endif
#define IN(k) (((PH_MASK >> (k)) & 1) && lo <= (k) && (k) < hi)
#define SEAM(k) do { if (IN(k) && IN((k) + 1)) xcd_barrier(bar); { unsigned z_; asm volatile("s_mov_b32 %0, 0" : "=s"(z_)); F.ws = args.ws + z_; F.out = args.out + z_; F.in = (kargp_t)args.in + z_; } } while (0)
#define B_XN WSP(bf16_t, WS_R3)
#define B_R1 WSP(bf16_t, WS_R1)
#define B_G WSP(bf16_t, WS_R2)
#define P_NG (F.in[7])
    const int bx = (int)blockIdx.x;
    if (IN(0)) { p0_prologue(F); } SEAM(0);
    if (IN(1)) { pg8::Gemm g{B_XN, WSP(bf16_t, WS_WIN0), TP, NP0, 1024}; pg8::StaticOrder S; S.init(TP, NP0, F.G, bx);
        pg8::EpiBf16T E{B_R1, NP0, 2, 4, 0.08838834764831845f, 8};
        pg8::gemm_phase<pg8::EpiBf16T, pg8::StaticOrder, true, true>(F.lds, g, S, E);
        sgemm_phase<0, 1024>(F, B_XN + (size_t)TP * DM, WSP(bf16_t, WS_WIN0), NP0); } SEAM(1);
    if (IN(2)) { m2_phase(F); } SEAM(2);
    if (IN(3)) { m3_phase(F); } SEAM(3);
    if (IN(4)) { pg8::Gemm g{B_XN, WSP(bf16_t, WS_WOUT0), TP, 1024, 1024}; pg8::StaticOrder S; S.init(TP, 1024, F.G, bx);
        pg8::EpiBf16T E{B_G, 1024, 0, 0, 1.0f, 1 << 30};
        pg8::gemm_phase<pg8::EpiBf16T, pg8::StaticOrder, true, true>(F.lds, g, S, E);
        sgemm_phase<1, 1024>(F, B_XN + (size_t)TP * DM, WSP(bf16_t, WS_WOUT0), 1024); } SEAM(4);
    if (IN(5)) { norm_phase<0>(F, F.in[0], F.in[1], B_G, P_NG + 1 * 1024); } SEAM(5);
    if (IN(6)) { pg8::Gemm g{WSP(bf16_t, WS_XB), WSP(bf16_t, WS_FIN0), TP, FF2, 1024}; pg8::StaticOrder S; S.init(TP, FF2, F.G, bx);
        pg8::EpiSwiglu E{B_R1, FFH, WSP(float, WS_RS)};
        pg8::gemm_phase<pg8::EpiSwiglu, pg8::StaticOrder, true, true>(F.lds, g, S, E);
        sgemm_phase<2, 1024>(F, WSP(bf16_t, WS_XB) + (size_t)TP * DM, WSP(bf16_t, WS_FIN0), FF2); } SEAM(6);
    if (IN(7)) { pg8::Gemm g{B_R1, WSP(bf16_t, WS_FOUT0), TP, 1024, FFH}; pg8::StaticOrder S; S.init(TP, 1024, F.G, bx);
        pg8::EpiBf16T E{B_G, 1024, 0, 0, 1.0f, 1 << 30};
        pg8::gemm_phase<pg8::EpiBf16T, pg8::StaticOrder, true, true>(F.lds, g, S, E);
        sgemm_phase<1, FFH>(F, B_R1 + (size_t)TP * FFH, WSP(bf16_t, WS_FOUT0), 1024); } SEAM(7);
    if (IN(8)) { norm_phase<1>(F, nullptr, nullptr, B_G, P_NG + 3 * 1024); } SEAM(8);
    if (IN(9)) { pg8::Gemm g{WSP(bf16_t, WS_XB), WSP(bf16_t, WS_KVQ), TP, 3072, 1024}; pg8::StaticOrder S; S.init(TP, 3072, F.G, bx);
        pg8::EpiKVQ E{B_R1, F.out, QSCALE, WSP(float, WS_RS)};
        pg8::gemm_phase<pg8::EpiKVQ, pg8::StaticOrder, true, true>(F.lds, g, S, E);
        sgemm_phase<3, 1024>(F, WSP(bf16_t, WS_XB) + (size_t)TP * DM, WSP(bf16_t, WS_KVQ), 3072); } SEAM(9);
    if (IN(10)) { attn_phase(F, true, MK_N_LAUNCHES == 1); } SEAM(10);
    if (MK_N_LAUNCHES != 1 && IN(16)) { attn_phase(F, false, true); }
#ifdef DIAGV
    if (MK_N_LAUNCHES != 1 && IN(17)) { attn_phase_diag(F); }
#endif
#ifdef GDIAG
    if (MK_N_LAUNCHES != 1 && IN(18)) { pg8::Gemm g{WSP(bf16_t, WS_XB), WSP(bf16_t, WS_FIN0), TP, FF2, 1024}; pg8::StaticOrder S; S.init(TP, FF2, F.G, bx);
        pg8::EpiSwiglu E{B_R1, FFH, WSP(float, WS_RS)};
        pg8::gemm_phase<pg8::EpiSwiglu, pg8::StaticOrder, true, true, GDIAG>(F.lds, g, S, E); }
#endif
    if (IN(11)) { pg8::Gemm g{B_XN, WSP(bf16_t, WS_WO1), TP, 1024, 1024};
        pg8::SubOrder S; const int grp = bx & 7;
        if (F.G == 256) { S.S.init(TP, 1024, F.G, grp < 4 ? bx : bx - 4); S.i0 = grp < 4 ? 0 : 1; S.n = 1; } else { S.S.init(TP, 1024, F.G, bx); S.i0 = 0; S.n = 1 << 30; }
        pg8::EpiBf16T E{B_G, 1024, 0, 0, 1.0f, 1 << 30};
        pg8::gemm_phase<pg8::EpiBf16T, pg8::SubOrder, true, true>(F.lds, g, S, E);
        sgemm_phase<1, 1024>(F, B_XN + (size_t)TP * DM, WSP(bf16_t, WS_WO1), 1024); } SEAM(11);
    if (IN(12)) { norm_phase<1>(F, nullptr, nullptr, B_G, P_NG + 5 * 1024); } SEAM(12);
    if (IN(13)) { pg8::Gemm g{WSP(bf16_t, WS_XB), WSP(bf16_t, WS_FIN1), TP, FF2, 1024}; pg8::StaticOrder S; S.init(TP, FF2, F.G, bx);
        pg8::EpiSwiglu E{B_R1, FFH, WSP(float, WS_RS)};
        pg8::gemm_phase<pg8::EpiSwiglu, pg8::StaticOrder, true, true>(F.lds, g, S, E);
        sgemm_phase<2, 1024>(F, WSP(bf16_t, WS_XB) + (size_t)TP * DM, WSP(bf16_t, WS_FIN1), FF2); } SEAM(13);
    if (IN(14)) { pg8::Gemm g{B_R1, WSP(bf16_t, WS_FOUT1), TP, 1024, FFH}; pg8::StaticOrder S; S.init(TP, 1024, F.G, bx);
        pg8::EpiBf16T E{B_G, 1024, 0, 0, 1.0f, 1 << 30};
        pg8::gemm_phase<pg8::EpiBf16T, pg8::StaticOrder, true, true>(F.lds, g, S, E);
        sgemm_phase<1, FFH>(F, B_R1 + (size_t)TP * FFH, WSP(bf16_t, WS_FOUT1), 1024); } SEAM(14);
    if (IN(15)) { norm_phase<2>(F, nullptr, nullptr, B_G, P_NG + 7 * 1024); }
#undef IN
#undef SEAM
#undef B_XN
#undef B_R1
#undef B_G
#undef P_NG
}

extern "C" void kernel_launch(void* const* d_in, const int* in_sizes, int n_in, void* d_out, int out_size, void* d_ws, size_t ws_size, hipStream_t stream) {
    static int grid = 0;
    if (grid == 0) {
        if (n_in != 24 || (size_t)out_size != O_END || ws_size < WS_END) { fprintf(stderr, "kernel_launch: unexpected shapes: n_in %d out %d ws %zu (need 24, %zu, >= %zu); nothing launched\n", n_in, out_size, ws_size, (size_t)O_END, (size_t)WS_END); grid = -1; return; }
        int dev = 0, cus = 0, per_cu = 0;
        if (hipGetDevice(&dev) != hipSuccess || hipDeviceGetAttribute(&cus, hipDeviceAttributeMultiprocessorCount, dev) != hipSuccess) { fprintf(stderr, "kernel_launch: device query failed\n"); grid = -1; return; }
        if (hipFuncSetAttribute((const void*)mk_fwd, hipFuncAttributeMaxDynamicSharedMemorySize, LDS_BYTES) != hipSuccess) { fprintf(stderr, "kernel_launch: hipFuncSetAttribute failed\n"); grid = -1; return; }
        if (hipOccupancyMaxActiveBlocksPerMultiprocessor(&per_cu, (const void*)mk_fwd, NWAVES * 64, LDS_BYTES) != hipSuccess || per_cu < 1) { fprintf(stderr, "kernel_launch: occupancy query reports %d blocks per CU\n", per_cu); }
        (void)hipGetLastError();
        grid = cus;
    }
    if (grid < 0) return;
    if (hipMemsetAsync((char*)d_ws + WS_CTL, 0, CTL_ZERO_BYTES, stream) != hipSuccess) { fprintf(stderr, "kernel_launch: memset failed\n"); return; }
    Args a{};
    for (int i = 0; i < 24; ++i) a.in[i] = (const float*)d_in[i];
    a.out = (float*)d_out; a.ws = (unsigned char*)d_ws;
    for (int l_ = 0; l_ < MK_N_LAUNCHES; ++l_) {
        const int li = (MK_N_LAUNCHES == 1) ? 0 : (l_ <= 10 ? l_ : l_ == 11 ? 16 : (MK_N_LAUNCHES == 18 ? (l_ == 12 ? 17 : l_ - 2) : l_ - 1));
        a.ph_lo = (MK_N_LAUNCHES == 1) ? 0 : li; a.ph_hi = (MK_N_LAUNCHES == 1) ? N_PHASES : li + 1;
        hipLaunchKernelGGL(mk_fwd, dim3(grid), dim3(NWAVES * 64), LDS_BYTES, stream, a);
#ifdef GDIAG
        if (MK_N_LAUNCHES > 1 && li == 6) { Args d = a; d.ph_lo = 18; d.ph_hi = 19; for (int r_ = 0; r_ < 3; ++r_) hipLaunchKernelGGL(mk_fwd, dim3(grid), dim3(NWAVES * 64), LDS_BYTES, stream, d); }
#endif
#ifdef PH_REP
        if (MK_N_LAUNCHES > 1 && ((PH_REP >> li) & 1)) for (int r_ = 0; r_ < 3; ++r_) hipLaunchKernelGGL(mk_fwd, dim3(grid), dim3(NWAVES * 64), LDS_BYTES, stream, a);
#endif
        const hipError_t le = hipPeekAtLastError();
        if (le != hipSuccess) { fprintf(stderr, "kernel_launch: launch %d failed: %s\n", li, hipGetErrorName(le)); break; }
    }
}
```
